# Optimizing an MI355X kernel written in HIP

```python
import jax, jax.numpy as jnp
from jax import lax
import numpy as np

D_MODEL = 1024
BATCH = 4
SEQ = 4096
DEPTH = 2

N_A_LAYERS = DEPTH // 2
N_B_LAYERS = DEPTH - N_A_LAYERS
HG_HEADS = 8
HG_DK = D_MODEL // HG_HEADS
HG_DV = D_MODEL // HG_HEADS
HG_CHUNK = 32
SW_Q_HEADS = 16
SW_KV_HEADS = 4
SW_HEAD_DIM = D_MODEL // SW_Q_HEADS
SW_GROUP = SW_Q_HEADS // SW_KV_HEADS
SW_WINDOW = 128
ROPE_THETA = 500000.0
ROPE_DIMS = SW_HEAD_DIM // 4
PEER_HEADS = 8
PEER_NKEYS = 128
PEER_EXPERTS = PEER_NKEYS * PEER_NKEYS
PEER_QDIM = 256
PEER_HALF = PEER_QDIM // 2
PEER_TOPK = 16
PEER_TOKEN_BLOCK = 128
DN_ALPHA = (2.0 * DEPTH) ** 0.25
DN_BETA = (8.0 * DEPTH) ** -0.25
LN_EPS = 1e-5
RMS_EPS = 1e-6

kernel_name = "yoco_hgrn2_swa_sink_peer_deepnorm"

F32 = jnp.float32


def _layernorm(x, g, b):
    xf = x.astype(F32)
    mu = jnp.mean(xf, -1, keepdims=True)
    var = jnp.mean(jnp.square(xf - mu), -1, keepdims=True)
    y = (xf - mu) * lax.rsqrt(var + LN_EPS) * g.astype(F32) + b.astype(F32)
    return y.astype(x.dtype)


def _rope_tables(positions):
    inv = ROPE_THETA ** (-jnp.arange(0, ROPE_DIMS, 2, dtype=F32) / ROPE_DIMS)
    ang = positions.astype(F32)[..., None] * inv
    return jnp.cos(ang), jnp.sin(ang)


def _partial_rope(x, cos, sin):
    half = ROPE_DIMS // 2
    xf = x.astype(F32)
    x1 = xf[..., :half]
    x2 = xf[..., half:ROPE_DIMS]
    c = cos[:, :, None, :]
    s = sin[:, :, None, :]
    out = jnp.concatenate([x1 * c - x2 * s, x2 * c + x1 * s, xf[..., ROPE_DIMS:]], axis=-1)
    return out.astype(x.dtype)


def _hgrn2(h, w_in, lb, norm_w, w_o):
    B, S, _ = h.shape
    H, DK, DV, C = HG_HEADS, HG_DK, HG_DV, HG_CHUNK
    nC = S // C
    proj = h @ w_in
    q, f, i, g = jnp.split(proj, [H * DK, 2 * H * DK, 2 * H * DK + H * DV], axis=-1)
    q = jax.nn.silu(q.astype(F32))
    lbf = lb.astype(F32)
    fg = lbf + (1.0 - lbf) * jax.nn.sigmoid(f.astype(F32))
    k = 1.0 - fg
    logf = jnp.log(fg)

    def chunk(t, d):
        return t.reshape(B, nC, C, H, d).transpose(1, 0, 3, 2, 4)

    qc, kc, lc = chunk(q, DK), chunk(k, DK), chunk(logf, DK)
    vc = chunk(i.astype(F32), DV)
    b = jnp.cumsum(lc, axis=3)
    b_last = b[:, :, :, -1:, :]
    qd = qc * jnp.exp(b)
    kd = kc * jnp.exp(-b)
    kl = kc * jnp.exp(b_last - b)
    causal = jnp.tril(jnp.ones((C, C), dtype=bool))
    att = jnp.where(causal, jnp.einsum('nbhid,nbhjd->nbhij', qd, kd), 0.0)
    o_intra = jnp.einsum('nbhij,nbhje->nbhie', att, vc)

    def step(state, xs):
        qd_n, kl_n, v_n, dec_n = xs
        o = jnp.einsum('bhid,bhde->bhie', qd_n, state)
        state = state * dec_n[..., None] + jnp.einsum('bhid,bhie->bhde', kl_n, v_n)
        return state, o

    s0 = jnp.zeros((B, H, DK, DV), F32)
    _, o_inter = lax.scan(step, s0, (qd, kl, vc, jnp.exp(b_last[:, :, :, 0, :])))
    o = (o_intra + o_inter).transpose(1, 0, 3, 2, 4).reshape(B, S, H, DV)
    o = o * lax.rsqrt(jnp.mean(jnp.square(o), -1, keepdims=True) + RMS_EPS)
    o = o.reshape(B, S, H * DV) * norm_w.astype(F32) * jax.nn.silu(g.astype(F32))
    return o.astype(h.dtype) @ w_o


def _shared_kv(h, w_kv, cos, sin):
    B, S, _ = h.shape
    kv = (h @ w_kv).reshape(B, S, 2, SW_KV_HEADS, SW_HEAD_DIM)
    k = _partial_rope(kv[:, :, 0], cos, sin)
    v = kv[:, :, 1]
    return k, v


def _swa_sink(h, k, v, w_q, sinks, w_o, cos, sin):
    B, S, _ = h.shape
    W, NKV, G, HD = SW_WINDOW, SW_KV_HEADS, SW_GROUP, SW_HEAD_DIM
    nb = S // W
    q = _partial_rope((h @ w_q).reshape(B, S, SW_Q_HEADS, HD), cos, sin)
    qb = q.reshape(B, nb, W, NKV, G, HD)

    def band(t):
        tp = jnp.pad(t, ((0, 0), (W, 0), (0, 0), (0, 0)))
        prev = tp[:, :S].reshape(B, nb, W, NKV, HD)
        cur = t.reshape(B, nb, W, NKV, HD)
        return jnp.concatenate([prev, cur], axis=2)

    kb, vb = band(k), band(v)
    logits = jnp.einsum('bnqhgd,bnkhd->bnhgqk', qb.astype(F32), kb.astype(F32)) * (HD ** -0.5)
    qi = jnp.arange(W)[:, None]
    kj = jnp.arange(2 * W)[None, :]
    diff = W + qi - kj
    in_win = (diff >= 0) & (diff < W)
    blk = jnp.arange(nb)[:, None, None]
    valid = in_win[None] & ((blk * W + kj[None] - W) >= 0)
    logits = jnp.where(valid[None, :, None, None], logits, -jnp.inf)
    sink = sinks.astype(F32).reshape(NKV, G)[None, None, :, :, None, None]
    full = jnp.concatenate([logits, jnp.broadcast_to(sink, logits.shape[:-1] + (1,))], axis=-1)
    p = jax.nn.softmax(full, axis=-1)[..., :-1]
    o = jnp.einsum('bnhgqk,bnkhd->bnqhgd', p, vb.astype(F32)).reshape(B, S, SW_Q_HEADS * HD)
    return o.astype(h.dtype) @ w_o


def _peer(h, w_pq, sub_keys, u_tab, v_tab):
    B, S, D = h.shape
    T = B * S
    K, NK, BLK = PEER_TOPK, PEER_NKEYS, PEER_TOKEN_BLOCK
    xf = h.reshape(T, D)
    q = (xf @ w_pq).astype(F32).reshape(T, PEER_HEADS, 2, PEER_HALF)
    s = jnp.einsum('thcd,hckd->thck', q, sub_keys.astype(F32))
    s1, i1 = lax.top_k(s[:, :, 0], K)
    s2, i2 = lax.top_k(s[:, :, 1], K)
    cand = (s1[..., :, None] + s2[..., None, :]).reshape(T, PEER_HEADS, K * K)
    cidx = (i1[..., :, None] * NK + i2[..., None, :]).reshape(T, PEER_HEADS, K * K)
    top_s, j = lax.top_k(cand, K)
    idx = jnp.take_along_axis(cidx, j, axis=-1)
    gate = jax.nn.softmax(top_s, axis=-1)
    nblk = T // BLK

    def block(args):
        xb, ib, gb = args
        a = jnp.einsum('td,thkd->thk', xb.astype(F32), u_tab[ib].astype(F32))
        w = gb * jax.nn.gelu(a, approximate=False)
        return jnp.einsum('thk,thkd->td', w, v_tab[ib].astype(F32))

    out = lax.map(block, (xf.reshape(nblk, BLK, D), idx.reshape(nblk, BLK, PEER_HEADS, K),
                          gate.reshape(nblk, BLK, PEER_HEADS, K)))
    return out.reshape(B, S, D).astype(h.dtype)


def setup_inputs(seed: int = 0) -> dict:
    key = jax.random.key(seed)
    ks = jax.random.split(key, 20)
    D = D_MODEL
    HGW = HG_HEADS * HG_DK
    nrm = jax.random.normal
    x = nrm(ks[0], (BATCH, SEQ, D), F32)
    positions = (jnp.arange(SEQ, dtype=jnp.int32)[None, :]
                 + jax.random.randint(ks[1], (BATCH, 1), 0, SEQ, dtype=jnp.int32))
    col_scale = jnp.concatenate([jnp.ones((2 * HGW,), F32), DN_BETA * jnp.ones((HGW,), F32),
                                 jnp.ones((HGW,), F32)]) * (D ** -0.5)
    hg_w_in = nrm(ks[2], (N_A_LAYERS, D, 4 * HGW), F32) * col_scale
    hg_lb = 0.1 * nrm(ks[3], (N_A_LAYERS + 1, HGW), F32)
    hg_norm_w = 1.0 + 0.02 * nrm(ks[4], (N_A_LAYERS, HG_HEADS * HG_DV), F32)
    hg_w_o = nrm(ks[5], (N_A_LAYERS, HG_HEADS * HG_DV, D), F32) * ((HG_HEADS * HG_DV) ** -0.5) * DN_BETA
    sw_w_q = nrm(ks[6], (N_B_LAYERS, D, SW_Q_HEADS * SW_HEAD_DIM), F32) * (D ** -0.5)
    sw_sinks = 0.5 * nrm(ks[7], (N_B_LAYERS, SW_Q_HEADS), F32)
    sw_w_o = nrm(ks[8], (N_B_LAYERS, SW_Q_HEADS * SW_HEAD_DIM, D), F32) * ((SW_Q_HEADS * SW_HEAD_DIM) ** -0.5) * DN_BETA
    kvw = SW_KV_HEADS * SW_HEAD_DIM
    w_kv = jnp.concatenate([nrm(ks[9], (D, kvw), F32) * (D ** -0.5),
                            nrm(ks[10], (D, kvw), F32) * (D ** -0.5) * DN_BETA], axis=1)
    peer_w_q = nrm(ks[11], (DEPTH, D, PEER_HEADS * PEER_QDIM), F32) * (D ** -0.5)
    peer_sub_keys = nrm(ks[12], (DEPTH, PEER_HEADS, 2, PEER_NKEYS, PEER_HALF), F32) * (PEER_HALF ** -0.5)
    peer_u = nrm(ks[13], (DEPTH, PEER_EXPERTS, D), F32) * (D ** -0.5)
    peer_v = nrm(ks[14], (DEPTH, PEER_EXPERTS, D), F32) * DN_BETA
    ln_mix_g = 1.0 + 0.02 * nrm(ks[15], (DEPTH, D), F32)
    ln_mix_b = 0.02 * nrm(ks[16], (DEPTH, D), F32)
    ln_ffn_g = 1.0 + 0.02 * nrm(ks[17], (DEPTH, D), F32)
    ln_ffn_b = 0.02 * nrm(ks[18], (DEPTH, D), F32)
    return {"x": x, "positions": positions, "hg_w_in": hg_w_in, "hg_lb": hg_lb,
            "hg_norm_w": hg_norm_w, "hg_w_o": hg_w_o, "sw_w_q": sw_w_q, "sw_sinks": sw_sinks,
            "sw_w_o": sw_w_o, "w_kv": w_kv, "peer_w_q": peer_w_q, "peer_sub_keys": peer_sub_keys,
            "peer_u": peer_u, "peer_v": peer_v, "ln_mix_g": ln_mix_g, "ln_mix_b": ln_mix_b,
            "ln_ffn_g": ln_ffn_g, "ln_ffn_b": ln_ffn_b}


def reference(x, positions, hg_w_in, hg_lb, hg_norm_w, hg_w_o, sw_w_q, sw_sinks, sw_w_o, w_kv,
              peer_w_q, peer_sub_keys, peer_u, peer_v, ln_mix_g, ln_mix_b, ln_ffn_g, ln_ffn_b):
    cos, sin = _rope_tables(positions)
    lb_all = jnp.cumsum(jax.nn.softmax(hg_lb.astype(F32), axis=0), axis=0)
    h = x
    k_sh = None
    v_sh = None
    for l in range(DEPTH):
        if l < N_A_LAYERS:
            mix = _hgrn2(h, hg_w_in[l], lb_all[l], hg_norm_w[l], hg_w_o[l])
        else:
            jb = l - N_A_LAYERS
            mix = _swa_sink(h, k_sh, v_sh, sw_w_q[jb], sw_sinks[jb], sw_w_o[jb], cos, sin)
        h = _layernorm(DN_ALPHA * h + mix, ln_mix_g[l], ln_mix_b[l])
        h = _layernorm(DN_ALPHA * h + _peer(h, peer_w_q[l], peer_sub_keys[l], peer_u[l], peer_v[l]),
                       ln_ffn_g[l], ln_ffn_b[l])
        if l == N_A_LAYERS - 1:
            k_sh, v_sh = _shared_kv(h, w_kv, cos, sin)
    return h
```

```cpp
#include <hip/hip_runtime.h>
#include <hip/hip_cooperative_groups.h>
#include <math.h>
#include <cstdio>
namespace pg8 {
#define PG8_LAS __attribute__((address_space(3)))
typedef unsigned short bf16_t;
typedef short bf16x8 __attribute__((ext_vector_type(8)));
typedef float f32x4 __attribute__((ext_vector_type(4)));
typedef unsigned u32x4 __attribute__((ext_vector_type(4)));
constexpr int BM = 256, BK = 64, HALF = 128, HTB = HALF * BK * 2  , STAGE_BYTES = 8 * HTB, NXCD = 8, WGM = 8;

__host__ __device__ __forceinline__ int lds_byte(int r, int c) { const int st = (r >> 4) * 2 + (c >> 5), rr = r & 15, cc = c & 31, ob = rr * 64 + cc * 2; return st * 1024 + (ob ^ (((ob >> 9) & 1) << 5)); }
__host__ __device__ __forceinline__ void stage_rc(int b, int& R, int& C) { const int st = b / 1024, sb = b % 1024, swz = sb ^ (((sb >> 9) & 1) << 5); R = (st >> 1) * 16 + swz / 64; C = (st & 1) * 32 + (swz % 64) / 2; }
__host__ __device__ __forceinline__ int perm32(int rho) { const int n = rho >> 4, i = rho & 15; return 8 * (i >> 2) + 4 * n + (i & 3); }

struct Unit { int pm, pn; };
struct Gemm { const bf16_t* A; const bf16_t* Bt; int M, N, K; };

struct StaticOrder {
    int nM, nN, nwg, G, c;
    __host__ __device__ void init(int M, int N, int G_, int c_) { nM = M / BM; nN = N / BM; nwg = nM * nN; G = G_; c = c_; }
    __host__ __device__ bool next(int i, Unit& u) const {
        const long L = (long)i * G + c; if (L >= nwg) return false;
        int wgid = (int)L; { const int q = nwg / NXCD, r = nwg % NXCD, xcd = wgid % NXCD, off = wgid / NXCD; wgid = (xcd < r ? xcd * (q + 1) : r * (q + 1) + (xcd - r) * q) + off; }
        const int nig = WGM * nN, gid = wgid / nig, fm = gid * WGM, gsz = (nM - fm) < WGM ? (nM - fm) : WGM;
        u.pm = fm + ((wgid % nig) % gsz); u.pn = (wgid % nig) / gsz; return true;
    }
    __device__ __forceinline__ void a_ready(const Unit&) const {}
    __device__ __forceinline__ void done(const Unit&) const {}
};
typedef __bf16 bf16v2_t __attribute__((ext_vector_type(2)));
typedef float f32v2_t __attribute__((ext_vector_type(2)));
__device__ __forceinline__ unsigned cvt_pk_bf16(float lo, float hi) { const f32v2_t v = {lo, hi}; return __builtin_bit_cast(unsigned, __builtin_convertvector(v, bf16v2_t)); }
typedef float f32x2 __attribute__((ext_vector_type(2)));

template <class Epi, class Sched, bool STAMP = false>
__device__ __forceinline__ void gemm_phase(PG8_LAS unsigned char* lds, const Gemm g, const Sched& S, const Epi& E, unsigned long long* stamps) {
    const int tid = threadIdx.x, wid = __builtin_amdgcn_readfirstlane(tid >> 6), lane = tid & 63, wr = wid >> 2, wc = wid & 3, fr = lane & 15, fq = lane >> 4;
    const int K = g.K, nt = K / BK;
    int ts_lo = 0, ts_hi = 0, nts = 0; const unsigned long long rt_entry = STAMP ? (unsigned long long)wall_clock64() : 0ull;
#define PG8_STAMP() do { if (STAMP && wid == 0 && nts < 64) { const unsigned long long _c = (unsigned long long)clock64(); \
        ts_lo = (lane == nts) ? (int)(unsigned)_c : ts_lo; ts_hi = (lane == nts) ? (int)(unsigned)(_c >> 32) : ts_hi; ++nts; } } while (0)
    PG8_STAMP();
    unsigned voffA[2], voffB[2];
#pragma unroll
    for (int i = 0; i < 2; ++i) { int R, C; stage_rc(tid * 16 + i * 8192, R, C); const int Rb = Epi::PERM ? ((R & ~31) + perm32(R & 31)) : R;
        voffA[i] = (unsigned)(R * K + C) * 2u; voffB[i] = (unsigned)(Rb * K + C) * 2u; }
    const size_t kstep = (size_t)(BK * 2);
    const size_t hstep = (size_t)HALF * K * 2;
    const size_t tstep = 2 * hstep;
    const unsigned ldsw = (unsigned)wid * 1024u;
    const int aoff = lds_byte(wr * 64 + fr, fq * 8), boff = lds_byte(wc * 32 + fr, fq * 8);
#define PG8_SA(b, h) (((b) * 2 + (h)) * HTB)
#define PG8_SB(b, h) ((4 + (b) * 2 + (h)) * HTB)
#define PG8_STAGE(bufoff, gbase, voff) do { _Pragma("unroll") for (int _i = 0; _i < 2; ++_i) \
        __builtin_amdgcn_global_load_lds((const unsigned*)((const char*)(gbase) + (voff)[_i]), (PG8_LAS unsigned*)(lds + (bufoff) + ldsw + _i * 8192), 16, 0, 0); } while (0)
#define PG8_LDA(dst, b, h) do { _Pragma("unroll") for (int m = 0; m < 4; ++m) _Pragma("unroll") for (int k = 0; k < 2; ++k) dst[m][k] = *(const PG8_LAS bf16x8*)(lds + PG8_SA(b, h) + aoff + m * 2048 + k * 1024); } while (0)
#define PG8_LDB(dst, b, h) do { _Pragma("unroll") for (int n = 0; n < 2; ++n) _Pragma("unroll") for (int k = 0; k < 2; ++k) dst[n][k] = *(const PG8_LAS bf16x8*)(lds + PG8_SB(b, h) + boff + n * 2048 + k * 1024); } while (0)
#define PG8_MMA(ai, bj, At, Bt) do { __builtin_amdgcn_s_setprio(1); _Pragma("unroll") for (int m = 0; m < 4; ++m) _Pragma("unroll") for (int n = 0; n < 2; ++n) _Pragma("unroll") for (int k = 0; k < 2; ++k) \
        acc[ai][bj][m][n] = __builtin_amdgcn_mfma_f32_16x16x32_bf16(Bt[n][k], At[m][k], acc[ai][bj][m][n], 0, 0, 0); __builtin_amdgcn_s_setprio(0); } while (0)
#define PG8_WAIT_V(n) asm volatile("s_waitcnt vmcnt(" #n ")" ::: "memory")
#define PG8_WAIT_L(n) asm volatile("s_waitcnt lgkmcnt(" #n ")" ::: "memory")
#define PG8_BAR __builtin_amdgcn_s_barrier()
#define PG8_SCHED __builtin_amdgcn_sched_barrier(0)
    Unit cur, nxt; int ui = 0;
    if (!S.next(0, cur)) return;
    f32x4 acc[2][2][4][2];
#pragma unroll
    for (int a = 0; a < 2; ++a)
#pragma unroll
        for (int b = 0; b < 2; ++b)
#pragma unroll
            for (int m = 0; m < 4; ++m)
#pragma unroll
                for (int n = 0; n < 2; ++n) acc[a][b][m][n] = (f32x4){0.f, 0.f, 0.f, 0.f};
    bf16x8 At[4][2], B0[2][2], B1[2][2];
    const char* cA = (const char*)g.A + (size_t)cur.pm * tstep; const char* cB = (const char*)g.Bt + (size_t)cur.pn * tstep;
    S.a_ready(cur);
    PG8_STAGE(PG8_SB(0, 0), cB, voffB); PG8_STAGE(PG8_SA(0, 0), cA, voffA); PG8_STAGE(PG8_SB(0, 1), cB + hstep, voffB); PG8_STAGE(PG8_SA(0, 1), cA + hstep, voffA);
    if (wr == 1) PG8_BAR;
    PG8_WAIT_V(4); PG8_BAR;
    PG8_STAGE(PG8_SB(1, 0), cB + kstep, voffB); PG8_STAGE(PG8_SA(1, 0), cA + kstep, voffA); PG8_STAGE(PG8_SB(1, 1), cB + hstep + kstep, voffB);
    PG8_WAIT_V(6); PG8_BAR;
    PG8_STAMP();
    for (;;) {
        const bool has_next = S.next(ui + 1, nxt);
        const char* nA = has_next ? (const char*)g.A + (size_t)nxt.pm * tstep : cA; const char* nB = has_next ? (const char*)g.Bt + (size_t)nxt.pn * tstep : cB;
        for (int t = 0; t < nt; t += 2) {
            const bool last = (t == nt - 2);
            const char* a1 = cA + (size_t)(t + 1) * kstep;
            const char* a2 = last ? nA : cA + (size_t)(t + 2) * kstep; const char* b2 = last ? nB : cB + (size_t)(t + 2) * kstep;
            const char* a3 = a2 + kstep; const char* b3 = b2 + kstep;
            if (last && has_next) S.a_ready(nxt);
            PG8_LDB(B0, 0, 0); PG8_SCHED; PG8_LDA(At, 0, 0); PG8_STAGE(PG8_SA(1, 1), a1 + hstep, voffA);
            PG8_WAIT_L(8); PG8_BAR; PG8_WAIT_L(0); PG8_MMA(0, 0, At, B0); PG8_BAR; PG8_SCHED;
            PG8_LDB(B1, 0, 1); PG8_STAGE(PG8_SB(0, 0), b2, voffB);
            PG8_BAR; PG8_WAIT_L(0); PG8_MMA(0, 1, At, B1); PG8_BAR;
            PG8_LDA(At, 0, 1); PG8_STAGE(PG8_SA(0, 0), a2, voffA);
            PG8_BAR; PG8_WAIT_L(0); PG8_MMA(1, 0, At, B0); PG8_BAR; PG8_SCHED;
            PG8_STAGE(PG8_SB(0, 1), b2 + hstep, voffB);
            PG8_WAIT_V(6); PG8_BAR; PG8_MMA(1, 1, At, B1); PG8_BAR;
            PG8_LDB(B0, 1, 0); PG8_SCHED; PG8_LDA(At, 1, 0); PG8_STAGE(PG8_SA(0, 1), a2 + hstep, voffA);
            PG8_WAIT_L(8); PG8_BAR; PG8_WAIT_L(0); PG8_MMA(0, 0, At, B0); PG8_BAR; PG8_SCHED;
            PG8_LDB(B1, 1, 1); PG8_STAGE(PG8_SB(1, 0), b3, voffB);
            PG8_BAR; PG8_WAIT_L(0); PG8_MMA(0, 1, At, B1); PG8_BAR;
            PG8_LDA(At, 1, 1); PG8_STAGE(PG8_SA(1, 0), a3, voffA);
            PG8_BAR; PG8_WAIT_L(0); PG8_MMA(1, 0, At, B0); PG8_BAR; PG8_SCHED;
            PG8_STAGE(PG8_SB(1, 1), b3 + hstep, voffB);
            PG8_WAIT_V(6); PG8_BAR; PG8_MMA(1, 1, At, B1); PG8_BAR;
        }
        PG8_STAMP();
        if constexpr (!Epi::AFTER_DRAIN) { E(acc, cur, wr, wc, fr, fq); S.done(cur); }
        PG8_STAMP();
        if (!has_next) break;
#pragma unroll
        for (int a = 0; a < 2; ++a)
#pragma unroll
            for (int b = 0; b < 2; ++b)
#pragma unroll
                for (int m = 0; m < 4; ++m)
#pragma unroll
                    for (int n = 0; n < 2; ++n) acc[a][b][m][n] = (f32x4){0.f, 0.f, 0.f, 0.f};
        cur = nxt; cA = nA; cB = nB; ++ui;
    }
    PG8_WAIT_V(0);
    if (wr == 0) PG8_BAR;
    PG8_BAR;
    if constexpr (Epi::AFTER_DRAIN) { E.fused(acc, cur, wr, wc, fr, fq, lds, wid, lane); S.done(cur); }
    PG8_STAMP();
    if (STAMP && wid == 0) { stamps[lane] = lane < nts ? (((unsigned long long)(unsigned)ts_hi << 32) | (unsigned)ts_lo) : 0ull;
        if (lane == 62) stamps[62] = rt_entry; if (lane == 63) stamps[63] = (unsigned long long)wall_clock64(); }
#undef PG8_STAMP
#undef PG8_SA
#undef PG8_SB
#undef PG8_STAGE
#undef PG8_LDA
#undef PG8_LDB
#undef PG8_MMA
#undef PG8_WAIT_V
#undef PG8_WAIT_L
#undef PG8_BAR
#undef PG8_SCHED
}
}
namespace mk {
using pg8::bf16_t; using pg8::f32x4; using pg8::u32x4; using pg8::bf16x8; using pg8::Unit; using pg8::cvt_pk_bf16;
#define LAS __attribute__((address_space(3)))
typedef unsigned u32x2 __attribute__((ext_vector_type(2)));
typedef float f32x16 __attribute__((ext_vector_type(16)));
constexpr int T = 16384, D = 1024, SEQ = 4096, NTHR = 512;
constexpr float ALPHA = 1.41421356237f;
constexpr size_t MB = (size_t)1 << 20;
constexpr size_t WS_CTL = 0, WS_LBV = 1 * MB, WS_CS = 2 * MB, WS_WT_IN = 4 * MB, WS_WT_O = 12 * MB, WS_WT_QKV = 14 * MB, WS_WT_SWO = 17 * MB, WS_WT_PEER = 19 * MB,
                 WS_TABU = 32 * MB, WS_TABV = 96 * MB, WS_HA = 160 * MB, WS_HB16 = 224 * MB, WS_R3 = 256 * MB;
constexpr size_t R_QS = WS_R3, R_LF = WS_R3 + 32 * MB, R_VI = WS_R3 + 96 * MB, R_GS = WS_R3 + 128 * MB, R_ST = WS_R3 + 160 * MB, R_DEC = WS_R3 + 224 * MB, R_Z = WS_R3 + 160 * MB;
constexpr size_t R_SC = WS_R3, R_EIDX = WS_R3 + 128 * MB, R_GATE = WS_R3 + 136 * MB;
constexpr size_t R_Q = WS_R3, R_KB = WS_R3 + 32 * MB, R_VT = WS_R3 + 40 * MB, R_AO = WS_R3 + 48 * MB;

struct P {
  const float* x; const int* pos; const float *hg_w_in, *hg_lb, *hg_norm_w, *hg_w_o, *sw_w_q, *sw_sinks, *sw_w_o, *w_kv, *peer_w_q, *peer_sk, *peer_u, *peer_v,
      *ln_mix_g, *ln_mix_b, *ln_ffn_g, *ln_ffn_b;
  float* out; unsigned char* ws;
};

__device__ __forceinline__ float bf2f(unsigned short b) { return __uint_as_float(((unsigned)b) << 16); }
__device__ __forceinline__ float bflo(unsigned w) { return __uint_as_float(w << 16); }
__device__ __forceinline__ float bfhi(unsigned w) { return __uint_as_float(w & 0xffff0000u); }
__device__ __forceinline__ float fast_exp(float x) { return __builtin_amdgcn_exp2f(x * 1.44269504089f); }
__device__ __forceinline__ float fast_rcp(float x) { return __builtin_amdgcn_rcpf(x); }
__device__ __forceinline__ float fast_sigmoid(float x) { return fast_rcp(1.0f + fast_exp(-x)); }
__device__ __forceinline__ float fast_silu(float x) { return x * fast_sigmoid(x); }
__device__ __forceinline__ float wave_sum(float v) {
#pragma unroll
  for (int o = 1; o < 64; o <<= 1) v += __shfl_xor(v, o);
  return v;
}
__device__ __forceinline__ void cvt_stream(const float* __restrict__ src, bf16_t* __restrict__ dst, size_t n, size_t gtid, size_t gthreads) {
  const size_t n8 = n >> 3;
  for (size_t i = gtid; i < n8; i += gthreads) {
    const f32x4 a = ((const f32x4*)src)[2 * i], b = ((const f32x4*)src)[2 * i + 1];
    u32x4 o; o.x = cvt_pk_bf16(a.x, a.y); o.y = cvt_pk_bf16(a.z, a.w); o.z = cvt_pk_bf16(b.x, b.y); o.w = cvt_pk_bf16(b.z, b.w);
    ((u32x4*)dst)[i] = o;
  }
}
__device__ __forceinline__ void transpose_tile(const float* __restrict__ W, int K, int N, bf16_t* __restrict__ Wt, int row_off, int tile, LAS float* scr, int tid) {
  const int ntn = N / 64, kb = tile / ntn, nbk = tile % ntn, k0 = kb * 64, n0 = nbk * 64;
  { const int k = tid >> 3, n8 = (tid & 7) * 8;
    const f32x4 a = *(const f32x4*)(W + (size_t)(k0 + k) * N + n0 + n8), b = *(const f32x4*)(W + (size_t)(k0 + k) * N + n0 + n8 + 4);
    LAS float* s = scr + k * 65 + n8; s[0] = a.x; s[1] = a.y; s[2] = a.z; s[3] = a.w; s[4] = b.x; s[5] = b.y; s[6] = b.z; s[7] = b.w; }
  __syncthreads();
  { const int n = tid >> 3, k8 = (tid & 7) * 8; const LAS float* s = scr + k8 * 65 + n;
    u32x4 o; o.x = cvt_pk_bf16(s[0], s[65]); o.y = cvt_pk_bf16(s[130], s[195]); o.z = cvt_pk_bf16(s[260], s[325]); o.w = cvt_pk_bf16(s[390], s[455]);
    *(u32x4*)(Wt + (size_t)(row_off + n0 + n) * K + k0 + k8) = o; }
  __syncthreads();
}
__device__ __forceinline__ void peer_fold_item(const P& p, int item, LAS float* lds, int tid) {
  const int kt = item & 15, hc = (item >> 4) & 15, l = item >> 8, k0 = kt * 64;
  LAS float* sks = lds;
  LAS float* wqs = lds + 128 * 132;
  const float* SK = p.peer_sk + ((size_t)l * 16 + hc) * 128 * 128;
  const float* WQ = p.peer_w_q + (size_t)l * 1024 * 2048 + hc * 128;
  { const int key = tid & 127, dq = tid >> 7;
#pragma unroll
    for (int j = 0; j < 8; ++j) { const int d4 = (dq + 4 * j) * 4; const f32x4 v = *(const f32x4*)(SK + key * 128 + d4);
      sks[(d4 + 0) * 132 + key] = v.x; sks[(d4 + 1) * 132 + key] = v.y; sks[(d4 + 2) * 132 + key] = v.z; sks[(d4 + 3) * 132 + key] = v.w; } }
  { const int k = tid & 63, dq = tid >> 6;
#pragma unroll
    for (int j = 0; j < 4; ++j) { const int d4 = (dq + 8 * j) * 4; const f32x4 v = *(const f32x4*)(WQ + (size_t)(k0 + k) * 2048 + d4);
      wqs[(d4 + 0) * 68 + k] = v.x; wqs[(d4 + 1) * 68 + k] = v.y; wqs[(d4 + 2) * 68 + k] = v.z; wqs[(d4 + 3) * 68 + k] = v.w; } }
  __syncthreads();
  const int kq = tid & 15, keyq = tid >> 4;
  float acc[4][4];
#pragma unroll
  for (int i = 0; i < 4; ++i)
#pragma unroll
    for (int j = 0; j < 4; ++j) acc[i][j] = 0.f;
#pragma unroll 4
  for (int d = 0; d < 128; ++d) {
    const f32x4 a = *(const LAS f32x4*)(sks + d * 132 + keyq * 4), b = *(const LAS f32x4*)(wqs + d * 68 + kq * 4);
    const float av[4] = {a.x, a.y, a.z, a.w}, bv[4] = {b.x, b.y, b.z, b.w};
#pragma unroll
    for (int i = 0; i < 4; ++i)
#pragma unroll
      for (int j = 0; j < 4; ++j) acc[i][j] += av[i] * bv[j];
  }
  bf16_t* Wt = (bf16_t*)(p.ws + WS_WT_PEER) + ((size_t)l * 2048 + hc * 128) * 1024;
#pragma unroll
  for (int i = 0; i < 4; ++i) { u32x2 o; o.x = cvt_pk_bf16(acc[i][0], acc[i][1]); o.y = cvt_pk_bf16(acc[i][2], acc[i][3]);
    *(u32x2*)(Wt + (size_t)(keyq * 4 + i) * 1024 + k0 + kq * 4) = o; }
  __syncthreads();
}
__device__ __forceinline__ void phase_prep(const P& p, LAS unsigned char* lds, int bid, int nb) {
  const int tid = threadIdx.x; const size_t gtid = (size_t)bid * NTHR + tid, gth = (size_t)nb * NTHR;
  if (gtid < 1024) { const float a0 = p.hg_lb[gtid], a1 = p.hg_lb[1024 + gtid], mx = fmaxf(a0, a1), e0 = expf(a0 - mx), e1 = expf(a1 - mx); ((float*)(p.ws + WS_LBV))[gtid] = e0 / (e0 + e1); }
  for (size_t i = gtid; i < (size_t)T * 8; i += gth) { const int t = (int)(i >> 3), j = (int)(i & 7);
    const double inv = pow(500000.0, -(double)(2 * j) / 16.0), ang = (double)p.pos[t] * inv;
    ((float2*)(p.ws + WS_CS))[i] = make_float2((float)cos(ang), (float)sin(ang)); }
  LAS float* scr = (LAS float*)lds;
  constexpr int T_IN = 16 * 64, T_O = 16 * 16, T_Q = 16 * 16, T_KV = 16 * 8, T_SWO = 16 * 16, NT_ALL = T_IN + T_O + T_Q + T_KV + T_SWO;
  for (int it = bid; it < NT_ALL; it += nb) {
    int r = it;
    if (r < T_IN) { transpose_tile(p.hg_w_in, 1024, 4096, (bf16_t*)(p.ws + WS_WT_IN), 0, r, scr, tid); continue; } r -= T_IN;
    if (r < T_O) { transpose_tile(p.hg_w_o, 1024, 1024, (bf16_t*)(p.ws + WS_WT_O), 0, r, scr, tid); continue; } r -= T_O;
    if (r < T_Q) { transpose_tile(p.sw_w_q, 1024, 1024, (bf16_t*)(p.ws + WS_WT_QKV), 0, r, scr, tid); continue; } r -= T_Q;
    if (r < T_KV) { transpose_tile(p.w_kv, 1024, 512, (bf16_t*)(p.ws + WS_WT_QKV), 1024, r, scr, tid); continue; } r -= T_KV;
    transpose_tile(p.sw_w_o, 1024, 1024, (bf16_t*)(p.ws + WS_WT_SWO), 0, r, scr, tid);
  }
  for (int it = bid; it < 512; it += nb) peer_fold_item(p, it, scr, tid);
  cvt_stream(p.x, (bf16_t*)(p.ws + WS_HB16), (size_t)T * D, gtid, gth);
  cvt_stream(p.peer_u, (bf16_t*)(p.ws + WS_TABU), (size_t)2 * 16384 * 1024, gtid, gth);
  cvt_stream(p.peer_v, (bf16_t*)(p.ws + WS_TABV), (size_t)2 * 16384 * 1024, gtid, gth);
}
struct EpiHgrn {
  static constexpr bool PERM = true, AFTER_DRAIN = false;
  unsigned char* ws; float* lf; const float* lbv;
  __device__ __forceinline__ void operator()(const f32x4 (&acc)[2][2][4][2], const Unit& u, int wr, int wc, int fr, int fq) const {
    const int sec = u.pn >> 2, row0 = u.pm * 256 + wr * 64 + fr, col0 = (u.pn & 3) * 256 + wc * 32 + 8 * fq;
    if (sec == 1) {
      float lb[2][8];
#pragma unroll
      for (int bj = 0; bj < 2; ++bj) { const f32x4 a = *(const f32x4*)(lbv + col0 + bj * 128), b = *(const f32x4*)(lbv + col0 + bj * 128 + 4);
        lb[bj][0] = a.x; lb[bj][1] = a.y; lb[bj][2] = a.z; lb[bj][3] = a.w; lb[bj][4] = b.x; lb[bj][5] = b.y; lb[bj][6] = b.z; lb[bj][7] = b.w; }
#pragma unroll
      for (int ai = 0; ai < 2; ++ai)
#pragma unroll
        for (int m = 0; m < 4; ++m) { float* rowp = lf + (size_t)(row0 + ai * 128 + m * 16) * 1024 + col0;
#pragma unroll
          for (int bj = 0; bj < 2; ++bj) { f32x4 o[2];
#pragma unroll
            for (int n = 0; n < 2; ++n)
#pragma unroll
              for (int j = 0; j < 4; ++j) { const float l = lb[bj][4 * n + j]; o[n][j] = __logf(l + (1.0f - l) * fast_sigmoid(acc[ai][bj][m][n][j])); }
            *(f32x4*)(rowp + bj * 128) = o[0]; *(f32x4*)(rowp + bj * 128 + 4) = o[1]; } }
    } else {
      const size_t doff = sec == 0 ? R_QS : (sec == 2 ? R_VI : R_GS);
      bf16_t* dst = (bf16_t*)(ws + doff);
#pragma unroll
      for (int ai = 0; ai < 2; ++ai)
#pragma unroll
        for (int m = 0; m < 4; ++m) { bf16_t* rowp = dst + (size_t)(row0 + ai * 128 + m * 16) * 1024 + col0;
#pragma unroll
          for (int bj = 0; bj < 2; ++bj) { f32x4 v0 = acc[ai][bj][m][0], v1 = acc[ai][bj][m][1];
            if (sec != 2) {
#pragma unroll
              for (int j = 0; j < 4; ++j) { v0[j] = fast_silu(v0[j]); v1[j] = fast_silu(v1[j]); } }
            u32x4 w; w.x = cvt_pk_bf16(v0[0], v0[1]); w.y = cvt_pk_bf16(v0[2], v0[3]); w.z = cvt_pk_bf16(v1[0], v1[1]); w.w = cvt_pk_bf16(v1[2], v1[3]);
            *(u32x4*)(rowp + bj * 128) = w; } }
    }
  }
};
struct EpiResid {
  static constexpr bool PERM = false, AFTER_DRAIN = false;
  const float* res; float* z;
  __device__ __forceinline__ void operator()(const f32x4 (&acc)[2][2][4][2], const Unit& u, int wr, int wc, int fr, int fq) const {
    const int row0 = u.pm * 256 + wr * 64 + fr, col0 = u.pn * 256 + wc * 32 + 4 * fq;
#pragma unroll
    for (int ai = 0; ai < 2; ++ai)
#pragma unroll
      for (int m = 0; m < 4; ++m) { const size_t off = (size_t)(row0 + ai * 128 + m * 16) * 1024 + col0;
#pragma unroll
        for (int bj = 0; bj < 2; ++bj)
#pragma unroll
          for (int n = 0; n < 2; ++n) { const f32x4 r = *(const f32x4*)(res + off + bj * 128 + n * 16); *(f32x4*)(z + off + bj * 128 + n * 16) = acc[ai][bj][m][n] + ALPHA * r; } }
  }
};
struct EpiF32 {
  static constexpr bool PERM = false, AFTER_DRAIN = false;
  float* C; int ldc;
  __device__ __forceinline__ void operator()(const f32x4 (&acc)[2][2][4][2], const Unit& u, int wr, int wc, int fr, int fq) const {
    const int row0 = u.pm * 256 + wr * 64 + fr, col0 = u.pn * 256 + wc * 32 + 4 * fq;
#pragma unroll
    for (int ai = 0; ai < 2; ++ai)
#pragma unroll
      for (int m = 0; m < 4; ++m) { float* rowp = C + (size_t)(row0 + ai * 128 + m * 16) * ldc + col0;
#pragma unroll
        for (int bj = 0; bj < 2; ++bj)
#pragma unroll
          for (int n = 0; n < 2; ++n) *(f32x4*)(rowp + bj * 128 + n * 16) = acc[ai][bj][m][n]; }
  }
};

template <class Epi>
__device__ __forceinline__ void run_gemm(LAS unsigned char* lds, const bf16_t* A, const bf16_t* Bt, int M, int N, int K, const Epi& E, int bid, int nb) {
  pg8::Gemm g; g.A = A; g.Bt = Bt; g.M = M; g.N = N; g.K = K;
  pg8::StaticOrder S; S.init(M, N, nb, bid);
  pg8::gemm_phase<Epi, pg8::StaticOrder, false>(lds, g, S, E, nullptr);
}
__device__ __forceinline__ void phase_gemm1(const P& p, LAS unsigned char* lds, int bid, int nb) {
  EpiHgrn E; E.ws = p.ws; E.lf = (float*)(p.ws + R_LF); E.lbv = (const float*)(p.ws + WS_LBV);
  run_gemm(lds, (const bf16_t*)(p.ws + WS_HB16), (const bf16_t*)(p.ws + WS_WT_IN), T, 4096, 1024, E, bid, nb);
}
#define MFMA32(a, b, c) __builtin_amdgcn_mfma_f32_32x32x16_bf16((a), (b), (c), 0, 0, 0)
constexpr int A_QD = 0, A_KD = 17408, A_KLT = 34816, A_VT = 53248, A_P = 71680, A_TOT = 80896;
__device__ __forceinline__ void phase_hgrn_a(const P& p, LAS unsigned char* lds, int bid, int nb) {
  const int tid = threadIdx.x, lane = tid & 63, wid = __builtin_amdgcn_readfirstlane(tid >> 6), l31 = lane & 31, hh = lane >> 5;
  LAS bf16_t* qdL = (LAS bf16_t*)(lds + A_QD); LAS bf16_t* kdL = (LAS bf16_t*)(lds + A_KD); LAS bf16_t* klT = (LAS bf16_t*)(lds + A_KLT);
  LAS bf16_t* vT = (LAS bf16_t*)(lds + A_VT); LAS bf16_t* PL = (LAS bf16_t*)(lds + A_P); LAS float* tot = (LAS float*)(lds + A_TOT);
  bf16_t* qs = (bf16_t*)(p.ws + R_QS); const float* lf = (const float*)(p.ws + R_LF); bf16_t* vi = (bf16_t*)(p.ws + R_VI);
  bf16_t* ST = (bf16_t*)(p.ws + R_ST); float* decs = (float*)(p.ws + R_DEC);
  const int d = tid & 127, rg = tid >> 7;
  for (int ch = bid; ch < 2048; ch += nb) {
    const int n = ch & 63, h = (ch >> 6) & 7, b = ch >> 9;
    const size_t t0 = (size_t)b * SEQ + n * 64;
    const size_t g0 = (t0 + rg * 16) * 1024 + h * 128 + d;
    float lfv[16], qv[16], vv[16];
#pragma unroll
    for (int r = 0; r < 16; ++r) { lfv[r] = lf[g0 + (size_t)r * 1024]; qv[r] = bf2f(qs[g0 + (size_t)r * 1024]); vv[r] = bf2f(vi[g0 + (size_t)r * 1024]); }
    float bl[16]; float run = 0.f;
#pragma unroll
    for (int r = 0; r < 16; ++r) { run += lfv[r]; bl[r] = run; }
    tot[rg * 128 + d] = run;
    __syncthreads();
    float off = 0.f, total = 0.f;
#pragma unroll
    for (int g = 0; g < 4; ++g) { const float tg = tot[g * 128 + d]; off += (g < rg) ? tg : 0.f; total += tg; }
    unsigned klp[8], vtp[8];
#pragma unroll
    for (int r = 0; r < 16; r += 2) {
      float qd2[2], kd2[2], kl2[2];
#pragma unroll
      for (int u = 0; u < 2; ++u) { const float bb = off + bl[r + u], k = 1.0f - fast_exp(lfv[r + u]);
        qd2[u] = qv[r + u] * fast_exp(bb); kd2[u] = k * fast_exp(-bb); kl2[u] = k * fast_exp(total - bb); }
      const unsigned qq = cvt_pk_bf16(qd2[0], qd2[1]), kk = cvt_pk_bf16(kd2[0], kd2[1]);
      qdL[(rg * 16 + r) * 136 + d] = (bf16_t)(qq & 0xffffu); qdL[(rg * 16 + r + 1) * 136 + d] = (bf16_t)(qq >> 16);
      kdL[(rg * 16 + r) * 136 + d] = (bf16_t)(kk & 0xffffu); kdL[(rg * 16 + r + 1) * 136 + d] = (bf16_t)(kk >> 16);
      qs[g0 + (size_t)r * 1024] = (bf16_t)(qq & 0xffffu); qs[g0 + (size_t)(r + 1) * 1024] = (bf16_t)(qq >> 16);
      klp[r >> 1] = cvt_pk_bf16(kl2[0], kl2[1]); vtp[r >> 1] = cvt_pk_bf16(vv[r], vv[r + 1]);
    }
    *(LAS u32x4*)(klT + d * 72 + rg * 16) = (u32x4){klp[0], klp[1], klp[2], klp[3]}; *(LAS u32x4*)(klT + d * 72 + rg * 16 + 8) = (u32x4){klp[4], klp[5], klp[6], klp[7]};
    *(LAS u32x4*)(vT + d * 72 + rg * 16) = (u32x4){vtp[0], vtp[1], vtp[2], vtp[3]}; *(LAS u32x4*)(vT + d * 72 + rg * 16 + 8) = (u32x4){vtp[4], vtp[5], vtp[6], vtp[7]};
    if (rg == 0) decs[(size_t)ch * 128 + d] = fast_exp(total);
    __syncthreads();
    if (wid < 3) {
      const int jt = (wid == 2) ? 1 : 0, it = (wid == 0) ? 0 : 1;
      f32x16 c; for (int i = 0; i < 16; ++i) c[i] = 0.f;
#pragma unroll
      for (int ks = 0; ks < 8; ++ks) { const bf16x8 a = *(const LAS bf16x8*)(kdL + (jt * 32 + l31) * 136 + ks * 16 + hh * 8), bq = *(const LAS bf16x8*)(qdL + (it * 32 + l31) * 136 + ks * 16 + hh * 8);
        c = MFMA32(a, bq, c); }
      const int i = it * 32 + l31;
#pragma unroll
      for (int g = 0; g < 4; ++g) { const int j0 = jt * 32 + 8 * g + 4 * hh; float v[4];
#pragma unroll
        for (int u = 0; u < 4; ++u) v[u] = (j0 + u <= i) ? c[4 * g + u] : 0.f;
        *(LAS u32x2*)(PL + i * 72 + j0) = (u32x2){cvt_pk_bf16(v[0], v[1]), cvt_pk_bf16(v[2], v[3])}; }
    }
    { const int tbase = (wid >= 3) ? (wid - 3) * 2 : 10 + wid * 2;
#pragma unroll
      for (int tt = 0; tt < 2; ++tt) { const int tile = tbase + tt, et = tile >> 2, dt = tile & 3;
        f32x16 c; for (int i = 0; i < 16; ++i) c[i] = 0.f;
#pragma unroll
        for (int ks = 0; ks < 4; ++ks) { const bf16x8 a = *(const LAS bf16x8*)(vT + (et * 32 + l31) * 72 + ks * 16 + hh * 8), bk = *(const LAS bf16x8*)(klT + (dt * 32 + l31) * 72 + ks * 16 + hh * 8);
          c = MFMA32(a, bk, c); }
        bf16_t* dst = ST + ((size_t)ch * 128 + et * 32 + 4 * hh) * 128 + dt * 32 + l31;
#pragma unroll
        for (int g = 0; g < 4; ++g)
#pragma unroll
          for (int u = 0; u < 4; u += 2) { const unsigned w = cvt_pk_bf16(c[4 * g + u], c[4 * g + u + 1]);
            dst[(size_t)(8 * g + u) * 128] = (bf16_t)(w & 0xffffu); dst[(size_t)(8 * g + u + 1) * 128] = (bf16_t)(w >> 16); } }
    }
    __syncthreads();
    { const int it = wid >> 2, et = wid & 3;
      f32x16 c; for (int i = 0; i < 16; ++i) c[i] = 0.f;
#pragma unroll
      for (int ks = 0; ks < 4; ++ks) if (ks < 2 + 2 * it) { const bf16x8 a = *(const LAS bf16x8*)(PL + (it * 32 + l31) * 72 + ks * 16 + hh * 8), bv = *(const LAS bf16x8*)(vT + (et * 32 + l31) * 72 + ks * 16 + hh * 8);
        c = MFMA32(a, bv, c); }
      bf16_t* dst = vi + (t0 + it * 32 + 4 * hh) * 1024 + h * 128 + et * 32 + l31;
#pragma unroll
      for (int g = 0; g < 4; ++g)
#pragma unroll
        for (int u = 0; u < 4; u += 2) { const unsigned w = cvt_pk_bf16(c[4 * g + u], c[4 * g + u + 1]);
          dst[(size_t)(8 * g + u) * 1024] = (bf16_t)(w & 0xffffu); dst[(size_t)(8 * g + u + 1) * 1024] = (bf16_t)(w >> 16); }
    }
  }
}
__device__ __forceinline__ void phase_hgrn_b(const P& p, int bid, int nb) {
  bf16_t* ST = (bf16_t*)(p.ws + R_ST); const float* decs = (const float*)(p.ws + R_DEC);
  for (size_t it = (size_t)bid * NTHR + threadIdx.x; it < 131072; it += (size_t)nb * NTHR) {
    const int bh = (int)(it >> 12), quad = (int)(it & 4095), d4 = (quad & 31) * 4;
    bf16_t* base = ST + (size_t)bh * 64 * 16384 + quad * 4; const float* dbase = decs + (size_t)bh * 64 * 128 + d4;
    float s0 = 0.f, s1 = 0.f, s2 = 0.f, s3 = 0.f;
#pragma unroll 8
    for (int n = 0; n < 64; ++n) {
      const u32x2 loc = *(const u32x2*)(base + (size_t)n * 16384); const f32x4 dc = *(const f32x4*)(dbase + n * 128);
      *(u32x2*)(base + (size_t)n * 16384) = (u32x2){cvt_pk_bf16(s0, s1), cvt_pk_bf16(s2, s3)};
      s0 = s0 * dc.x + bflo(loc.x); s1 = s1 * dc.y + bfhi(loc.x); s2 = s2 * dc.z + bflo(loc.y); s3 = s3 * dc.w + bfhi(loc.y);
    }
  }
}
__device__ __forceinline__ void phase_hgrn_c(const P& p, int bid, int nb) {
  const int tid = threadIdx.x, lane = tid & 63, wid = tid >> 6, l31 = lane & 31, hh = lane >> 5;
  const bf16_t* qd = (const bf16_t*)(p.ws + R_QS); bf16_t* oi = (bf16_t*)(p.ws + R_VI); const bf16_t* gs = (const bf16_t*)(p.ws + R_GS); const bf16_t* ST = (const bf16_t*)(p.ws + R_ST);
  for (int wt = bid * 8 + wid; wt < 4096; wt += nb * 8) {
    const int ch = wt >> 1, half = wt & 1, n = ch & 63, h = (ch >> 6) & 7, b = ch >> 9;
    const size_t trow = ((size_t)b * SEQ + n * 64 + half * 32 + l31) * 1024 + h * 128;
    bf16x8 bq[8];
#pragma unroll
    for (int ks = 0; ks < 8; ++ks) bq[ks] = *(const bf16x8*)(qd + trow + ks * 16 + hh * 8);
    f32x16 acc[4];
#pragma unroll
    for (int et = 0; et < 4; ++et) {
      for (int i = 0; i < 16; ++i) acc[et][i] = 0.f;
      const bf16_t* ap = ST + ((size_t)ch * 128 + et * 32 + l31) * 128 + hh * 8;
#pragma unroll
      for (int ks = 0; ks < 8; ++ks) { const bf16x8 a = *(const bf16x8*)(ap + ks * 16); acc[et] = MFMA32(a, bq[ks], acc[et]); }
    }
    float ss = 0.f;
#pragma unroll
    for (int et = 0; et < 4; ++et)
#pragma unroll
      for (int g = 0; g < 4; ++g) { const u32x2 w = *(const u32x2*)(oi + trow + et * 32 + 8 * g + 4 * hh);
        acc[et][4 * g] += bflo(w.x); acc[et][4 * g + 1] += bfhi(w.x); acc[et][4 * g + 2] += bflo(w.y); acc[et][4 * g + 3] += bfhi(w.y);
        ss += acc[et][4 * g] * acc[et][4 * g] + acc[et][4 * g + 1] * acc[et][4 * g + 1] + acc[et][4 * g + 2] * acc[et][4 * g + 2] + acc[et][4 * g + 3] * acc[et][4 * g + 3]; }
    ss += __shfl_xor(ss, 32);
    const float r = rsqrtf(ss * (1.0f / 128.0f) + 1e-6f);
#pragma unroll
    for (int et = 0; et < 4; ++et)
#pragma unroll
      for (int g = 0; g < 4; ++g) { const int e0 = et * 32 + 8 * g + 4 * hh; const f32x4 nw = *(const f32x4*)(p.hg_norm_w + h * 128 + e0); const u32x2 gw = *(const u32x2*)(gs + trow + e0);
        const float o0 = acc[et][4 * g] * r * nw.x * bflo(gw.x), o1 = acc[et][4 * g + 1] * r * nw.y * bfhi(gw.x), o2 = acc[et][4 * g + 2] * r * nw.z * bflo(gw.y), o3 = acc[et][4 * g + 3] * r * nw.w * bfhi(gw.y);
        *(u32x2*)(oi + trow + e0) = (u32x2){cvt_pk_bf16(o0, o1), cvt_pk_bf16(o2, o3)}; }
  }
}
__device__ __forceinline__ void phase_gemm2(const P& p, LAS unsigned char* lds, int bid, int nb) {
  EpiResid E; E.res = p.x; E.z = (float*)(p.ws + R_Z);
  run_gemm(lds, (const bf16_t*)(p.ws + R_VI), (const bf16_t*)(p.ws + WS_WT_O), T, 1024, 1024, E, bid, nb);
}
__device__ __forceinline__ void phase_ln(const float* __restrict__ z, const float* __restrict__ g, const float* __restrict__ bb, float* __restrict__ hout, bf16_t* __restrict__ hb, int bid, int nb) {
  const int lane = threadIdx.x & 63, wid = threadIdx.x >> 6;
  for (int t = bid * 8 + wid; t < T; t += nb * 8) {
    f32x4 v[4]; float s = 0.f;
#pragma unroll
    for (int r = 0; r < 4; ++r) { v[r] = *(const f32x4*)(z + (size_t)t * 1024 + r * 256 + lane * 4); s += (v[r].x + v[r].y) + (v[r].z + v[r].w); }
    const float mu = wave_sum(s) * (1.0f / 1024.0f); float q = 0.f;
#pragma unroll
    for (int r = 0; r < 4; ++r) { v[r] = v[r] - mu; q += (v[r].x * v[r].x + v[r].y * v[r].y) + (v[r].z * v[r].z + v[r].w * v[r].w); }
    const float rs = rsqrtf(wave_sum(q) * (1.0f / 1024.0f) + 1e-5f);
#pragma unroll
    for (int r = 0; r < 4; ++r) { const int c = r * 256 + lane * 4; const f32x4 gg = *(const f32x4*)(g + c), b4 = *(const f32x4*)(bb + c);
      const f32x4 o = v[r] * rs * gg + b4;
      *(f32x4*)(hout + (size_t)t * 1024 + c) = o;
      *(u32x2*)(hb + (size_t)t * 1024 + c) = (u32x2){cvt_pk_bf16(o.x, o.y), cvt_pk_bf16(o.z, o.w)}; }
  }
}
typedef __bf16 bf16x2_t __attribute__((ext_vector_type(2)));
__device__ __forceinline__ float dot2bf(unsigned a, unsigned b, float c) { return __builtin_amdgcn_fdot2_f32_bf16(__builtin_bit_cast(bf16x2_t, a), __builtin_bit_cast(bf16x2_t, b), c, false); }
__device__ __forceinline__ void phase_peer_scores(const P& p, int l, LAS unsigned char* lds, int bid, int nb) {
  EpiF32 E; E.C = (float*)(p.ws + R_SC); E.ldc = 2048;
  run_gemm(lds, (const bf16_t*)(p.ws + WS_HB16), (const bf16_t*)(p.ws + WS_WT_PEER) + (size_t)l * 2048 * 1024, T, 2048, 1024, E, bid, nb);
}
__device__ __forceinline__ void ins16(float (&val)[16], int (&idx)[16], float x, int i) {
  if (x > val[15]) {
    val[15] = x; idx[15] = i;
#pragma unroll
    for (int j = 15; j >= 1; --j) {
      const bool sw = val[j] > val[j - 1];
      const float va = val[j], vb = val[j - 1]; const int ia = idx[j], ib = idx[j - 1];
      val[j] = sw ? vb : va; val[j - 1] = sw ? va : vb; idx[j] = sw ? ib : ia; idx[j - 1] = sw ? ia : ib;
    }
  }
}
__device__ __forceinline__ void phase_peer_topk(const P& p, int bid, int nb) {
  const float* sc = (const float*)(p.ws + R_SC); int* eidx = (int*)(p.ws + R_EIDX); float* gate = (float*)(p.ws + R_GATE);
  for (size_t gi = (size_t)bid * NTHR + threadIdx.x; gi < (size_t)T * 8; gi += (size_t)nb * NTHR) {
    const float* q = sc + gi * 256;
    float v1[16], v2[16], vc[16]; int i1[16], i2[16], ic[16];
#pragma unroll
    for (int j = 0; j < 16; ++j) { v1[j] = -INFINITY; v2[j] = -INFINITY; vc[j] = -INFINITY; i1[j] = 0; i2[j] = 0; ic[j] = 0; }
    for (int i = 0; i < 128; i += 4) { const f32x4 a = *(const f32x4*)(q + i); ins16(v1, i1, a.x, i); ins16(v1, i1, a.y, i + 1); ins16(v1, i1, a.z, i + 2); ins16(v1, i1, a.w, i + 3); }
    for (int i = 0; i < 128; i += 4) { const f32x4 a = *(const f32x4*)(q + 128 + i); ins16(v2, i2, a.x, i); ins16(v2, i2, a.y, i + 1); ins16(v2, i2, a.z, i + 2); ins16(v2, i2, a.w, i + 3); }
#pragma unroll
    for (int a = 0; a < 16; ++a)
#pragma unroll
      for (int b = 0; b < 16; ++b) if ((a + 1) * (b + 1) <= 16) ins16(vc, ic, v1[a] + v2[b], i1[a] * 128 + i2[b]);
    float s = 0.f; float e[16];
#pragma unroll
    for (int j = 0; j < 16; ++j) { e[j] = fast_exp(vc[j] - vc[0]); s += e[j]; }
    const float inv = 1.0f / s;
#pragma unroll
    for (int j = 0; j < 16; j += 4) { *(int4*)(eidx + gi * 16 + j) = make_int4(ic[j], ic[j + 1], ic[j + 2], ic[j + 3]); *(f32x4*)(gate + gi * 16 + j) = (f32x4){e[j] * inv, e[j + 1] * inv, e[j + 2] * inv, e[j + 3] * inv}; }
  }
}
template <int NBATCH>
__device__ __forceinline__ void phase_peer_gather(const P& p, int l, const float* __restrict__ hin, float* __restrict__ hout, int bid, int nb) {
  const int lane = threadIdx.x & 63, wid = threadIdx.x >> 6;
  const int* eidx = (const int*)(p.ws + R_EIDX); const float* gate = (const float*)(p.ws + R_GATE);
  const bf16_t* tabu = (const bf16_t*)(p.ws + WS_TABU) + (size_t)l * 16384 * 1024; const bf16_t* tabv = (const bf16_t*)(p.ws + WS_TABV) + (size_t)l * 16384 * 1024;
  const float* g = p.ln_ffn_g + l * 1024; const float* bb = p.ln_ffn_b + l * 1024; bf16_t* hb = (bf16_t*)(p.ws + WS_HB16);
  for (int t = bid * 8 + wid; t < T; t += nb * 8) {
    float x[16];
    { const f32x4 a0 = *(const f32x4*)(hin + (size_t)t * 1024 + lane * 8), a1 = *(const f32x4*)(hin + (size_t)t * 1024 + lane * 8 + 4),
                  a2 = *(const f32x4*)(hin + (size_t)t * 1024 + 512 + lane * 8), a3 = *(const f32x4*)(hin + (size_t)t * 1024 + 512 + lane * 8 + 4);
      x[0] = a0.x; x[1] = a0.y; x[2] = a0.z; x[3] = a0.w; x[4] = a1.x; x[5] = a1.y; x[6] = a1.z; x[7] = a1.w;
      x[8] = a2.x; x[9] = a2.y; x[10] = a2.z; x[11] = a2.w; x[12] = a3.x; x[13] = a3.y; x[14] = a3.z; x[15] = a3.w; }
    unsigned xb[8];
#pragma unroll
    for (int i = 0; i < 8; ++i) xb[i] = cvt_pk_bf16(x[2 * i], x[2 * i + 1]);
    const int id0 = eidx[(size_t)t * 128 + lane], id1 = eidx[(size_t)t * 128 + 64 + lane];
    const float gt0 = gate[(size_t)t * 128 + lane], gt1 = gate[(size_t)t * 128 + 64 + lane];
    float acc[16];
#pragma unroll
    for (int i = 0; i < 16; ++i) acc[i] = 0.f;
    for (int p0 = 0; p0 < 128; p0 += NBATCH) {
      u32x4 ur[NBATCH][2], vr[NBATCH][2];
#pragma unroll
      for (int k = 0; k < NBATCH; ++k) { const int pp = p0 + k; const int e = __builtin_amdgcn_readlane(pp < 64 ? id0 : id1, pp & 63);
        const bf16_t* up = tabu + (size_t)e * 1024 + lane * 8; const bf16_t* vp = tabv + (size_t)e * 1024 + lane * 8;
        ur[k][0] = *(const u32x4*)up; ur[k][1] = *(const u32x4*)(up + 512); vr[k][0] = *(const u32x4*)vp; vr[k][1] = *(const u32x4*)(vp + 512); }
#pragma unroll
      for (int k = 0; k < NBATCH; ++k) { const int pp = p0 + k;
        float d = 0.f;
        d = dot2bf(ur[k][0].x, xb[0], d); d = dot2bf(ur[k][0].y, xb[1], d); d = dot2bf(ur[k][0].z, xb[2], d); d = dot2bf(ur[k][0].w, xb[3], d);
        d = dot2bf(ur[k][1].x, xb[4], d); d = dot2bf(ur[k][1].y, xb[5], d); d = dot2bf(ur[k][1].z, xb[6], d); d = dot2bf(ur[k][1].w, xb[7], d);
        d = wave_sum(d);
        const float gt = __int_as_float(__builtin_amdgcn_readlane(__float_as_int(pp < 64 ? gt0 : gt1), pp & 63));
        const float w = gt * 0.5f * d * (1.0f + erff(d * 0.70710678118f));
        acc[0] += w * bflo(vr[k][0].x); acc[1] += w * bfhi(vr[k][0].x); acc[2] += w * bflo(vr[k][0].y); acc[3] += w * bfhi(vr[k][0].y);
        acc[4] += w * bflo(vr[k][0].z); acc[5] += w * bfhi(vr[k][0].z); acc[6] += w * bflo(vr[k][0].w); acc[7] += w * bfhi(vr[k][0].w);
        acc[8] += w * bflo(vr[k][1].x); acc[9] += w * bfhi(vr[k][1].x); acc[10] += w * bflo(vr[k][1].y); acc[11] += w * bfhi(vr[k][1].y);
        acc[12] += w * bflo(vr[k][1].z); acc[13] += w * bfhi(vr[k][1].z); acc[14] += w * bflo(vr[k][1].w); acc[15] += w * bfhi(vr[k][1].w); }
    }
    float s = 0.f;
#pragma unroll
    for (int i = 0; i < 16; ++i) { acc[i] += ALPHA * x[i]; s += acc[i]; }
    const float mu = wave_sum(s) * (1.0f / 1024.0f); float q = 0.f;
#pragma unroll
    for (int i = 0; i < 16; ++i) { acc[i] -= mu; q += acc[i] * acc[i]; }
    const float rs = rsqrtf(wave_sum(q) * (1.0f / 1024.0f) + 1e-5f);
#pragma unroll
    for (int hf = 0; hf < 2; ++hf) { const int c = hf * 512 + lane * 8;
      const f32x4 g0 = *(const f32x4*)(g + c), g1 = *(const f32x4*)(g + c + 4), b0 = *(const f32x4*)(bb + c), b1 = *(const f32x4*)(bb + c + 4);
      const f32x4 o0 = (f32x4){acc[8 * hf] * rs, acc[8 * hf + 1] * rs, acc[8 * hf + 2] * rs, acc[8 * hf + 3] * rs} * g0 + b0;
      const f32x4 o1 = (f32x4){acc[8 * hf + 4] * rs, acc[8 * hf + 5] * rs, acc[8 * hf + 6] * rs, acc[8 * hf + 7] * rs} * g1 + b1;
      *(f32x4*)(hout + (size_t)t * 1024 + c) = o0; *(f32x4*)(hout + (size_t)t * 1024 + c + 4) = o1;
      *(u32x4*)(hb + (size_t)t * 1024 + c) = (u32x4){cvt_pk_bf16(o0.x, o0.y), cvt_pk_bf16(o0.z, o0.w), cvt_pk_bf16(o1.x, o1.y), cvt_pk_bf16(o1.z, o1.w)}; }
  }
}
struct EpiAttn {
  static constexpr bool PERM = true, AFTER_DRAIN = false;
  unsigned char* ws; const float* cs;
  __device__ __forceinline__ void operator()(const f32x4 (&acc)[2][2][4][2], const Unit& u, int wr, int wc, int fr, int fq) const {
    const int row0 = u.pm * 256 + wr * 64 + fr;
    if (u.pn < 5) {
      const bool isq = u.pn < 4; const float scale = isq ? 0.125f : 1.0f; const int ld = isq ? 1024 : 256;
      bf16_t* dst = (bf16_t*)(ws + (isq ? R_Q : R_KB)) + (isq ? u.pn * 256 : 0) + wc * 32 + 8 * fq;
      const bool ropewave = (wc & 1) == 0;
#pragma unroll
      for (int ai = 0; ai < 2; ++ai)
#pragma unroll
        for (int m = 0; m < 4; ++m) { const int row = row0 + ai * 128 + m * 16;
          f32x4 c4[4];
          if (ropewave) {
#pragma unroll
            for (int i = 0; i < 4; ++i) c4[i] = *(const f32x4*)(cs + (size_t)row * 16 + i * 4); }
#pragma unroll
          for (int bj = 0; bj < 2; ++bj) { f32x4 v0 = acc[ai][bj][m][0], v1 = acc[ai][bj][m][1];
            if (ropewave) {
              f32x4 p0, p1;
#pragma unroll
              for (int j = 0; j < 4; ++j) { p0[j] = __shfl_xor(v0[j], 16); p1[j] = __shfl_xor(v1[j], 16); }
              const float sg = (fq == 0) ? -1.0f : 1.0f;
              if (fq < 2) {
                v0[0] = v0[0] * c4[0].x + sg * p0[0] * c4[0].y; v0[1] = v0[1] * c4[0].z + sg * p0[1] * c4[0].w; v0[2] = v0[2] * c4[1].x + sg * p0[2] * c4[1].y; v0[3] = v0[3] * c4[1].z + sg * p0[3] * c4[1].w;
                v1[0] = v1[0] * c4[2].x + sg * p1[0] * c4[2].y; v1[1] = v1[1] * c4[2].z + sg * p1[1] * c4[2].w; v1[2] = v1[2] * c4[3].x + sg * p1[2] * c4[3].y; v1[3] = v1[3] * c4[3].z + sg * p1[3] * c4[3].w;
              }
            }
            v0 = v0 * scale; v1 = v1 * scale;
            u32x4 w; w.x = cvt_pk_bf16(v0[0], v0[1]); w.y = cvt_pk_bf16(v0[2], v0[3]); w.z = cvt_pk_bf16(v1[0], v1[1]); w.w = cvt_pk_bf16(v1[2], v1[3]);
            *(u32x4*)(dst + (size_t)row * ld + bj * 128) = w; } }
    } else {
      bf16_t* vT = (bf16_t*)(ws + R_VT);
#pragma unroll
      for (int ai = 0; ai < 2; ++ai)
#pragma unroll
        for (int m = 0; m < 4; ++m) { const int row = row0 + ai * 128 + m * 16, b = row >> 12, s = row & 4095;
#pragma unroll
          for (int bj = 0; bj < 2; ++bj)
#pragma unroll
            for (int n = 0; n < 2; ++n) { const int col = bj * 128 + wc * 32 + 8 * fq + 4 * n;
              bf16_t* d0 = vT + ((size_t)(b * 4 + (col >> 6)) * 64 + (col & 63)) * 4096 + s;
              const unsigned w0 = cvt_pk_bf16(acc[ai][bj][m][n][0], acc[ai][bj][m][n][1]), w1 = cvt_pk_bf16(acc[ai][bj][m][n][2], acc[ai][bj][m][n][3]);
              d0[0] = (bf16_t)(w0 & 0xffffu); d0[4096] = (bf16_t)(w0 >> 16); d0[2 * 4096] = (bf16_t)(w1 & 0xffffu); d0[3 * 4096] = (bf16_t)(w1 >> 16); } }
    }
  }
};
__device__ __forceinline__ void phase_gemm_qkv(const P& p, LAS unsigned char* lds, int bid, int nb) {
  EpiAttn E; E.ws = p.ws; E.cs = (const float*)(p.ws + WS_CS);
  run_gemm(lds, (const bf16_t*)(p.ws + WS_HB16), (const bf16_t*)(p.ws + WS_WT_QKV), T, 1536, 1024, E, bid, nb);
}
__device__ __forceinline__ void phase_attn(const P& p, int bid, int nb) {
  const int lane = threadIdx.x & 63, wid = threadIdx.x >> 6, l31 = lane & 31, hh = lane >> 5;
  const bf16_t* q = (const bf16_t*)(p.ws + R_Q); const bf16_t* kb = (const bf16_t*)(p.ws + R_KB); const bf16_t* vT = (const bf16_t*)(p.ws + R_VT); bf16_t* ao = (bf16_t*)(p.ws + R_AO);
  for (int wt = bid * 8 + wid; wt < 8192; wt += nb * 8) {
    const int qb = wt & 127, hq = (wt >> 7) & 15, b = wt >> 11, kvh = hq >> 2, i0 = qb * 32, k0 = i0 - 128;
    const float sink = p.sw_sinks[hq];
    bf16x8 bq[4];
#pragma unroll
    for (int ks = 0; ks < 4; ++ks) bq[ks] = *(const bf16x8*)(q + (size_t)(b * SEQ + i0 + l31) * 1024 + hq * 64 + ks * 16 + hh * 8);
    f32x16 s[5];
#pragma unroll
    for (int kt = 0; kt < 5; ++kt) {
      for (int i = 0; i < 16; ++i) s[kt][i] = 0.f;
      const int kb0 = k0 + kt * 32;
      if (kb0 >= 0) {
        const bf16_t* kp = kb + (size_t)(b * SEQ + kb0 + l31) * 256 + kvh * 64 + hh * 8;
#pragma unroll
        for (int ks = 0; ks < 4; ++ks) { const bf16x8 a = *(const bf16x8*)(kp + ks * 16); s[kt] = MFMA32(a, bq[ks], s[kt]); }
      }
    }
    const int qp = i0 + l31; float m = sink;
#pragma unroll
    for (int kt = 0; kt < 5; ++kt)
#pragma unroll
      for (int r = 0; r < 16; ++r) { const int kp = k0 + kt * 32 + (r & 3) + 8 * (r >> 2) + 4 * hh; const bool valid = (kp >= 0) && (kp <= qp) && (kp > qp - 128);
        s[kt][r] = valid ? s[kt][r] : -INFINITY; m = fmaxf(m, s[kt][r]); }
    m = fmaxf(m, __shfl_xor(m, 32));
    float lsum = 0.f;
#pragma unroll
    for (int kt = 0; kt < 5; ++kt)
#pragma unroll
      for (int r = 0; r < 16; ++r) { const float e = fast_exp(s[kt][r] - m); s[kt][r] = e; lsum += e; }
    lsum += __shfl_xor(lsum, 32); lsum += fast_exp(sink - m);
    f32x16 o[2];
    for (int i = 0; i < 16; ++i) { o[0][i] = 0.f; o[1][i] = 0.f; }
#pragma unroll
    for (int kt = 0; kt < 5; ++kt) {
      const int kb0 = k0 + kt * 32;
      if (kb0 >= 0) {
#pragma unroll
        for (int st = 0; st < 2; ++st) {
          u32x4 pk; pk.x = cvt_pk_bf16(s[kt][8 * st], s[kt][8 * st + 1]); pk.y = cvt_pk_bf16(s[kt][8 * st + 2], s[kt][8 * st + 3]);
          pk.z = cvt_pk_bf16(s[kt][8 * st + 4], s[kt][8 * st + 5]); pk.w = cvt_pk_bf16(s[kt][8 * st + 6], s[kt][8 * st + 7]);
          const bf16x8 pb = __builtin_bit_cast(bf16x8, pk);
#pragma unroll
          for (int et = 0; et < 2; ++et) { const bf16_t* vp = vT + ((size_t)(b * 4 + kvh) * 64 + et * 32 + l31) * 4096 + kb0 + 16 * st + 4 * hh;
            const u32x2 lo = *(const u32x2*)vp, hi = *(const u32x2*)(vp + 8);
            const bf16x8 a = __builtin_bit_cast(bf16x8, (u32x4){lo.x, lo.y, hi.x, hi.y});
            o[et] = MFMA32(a, pb, o[et]); }
        }
      }
    }
    const float inv = 1.0f / lsum;
#pragma unroll
    for (int et = 0; et < 2; ++et)
#pragma unroll
      for (int g = 0; g < 4; ++g)
        *(u32x2*)(ao + (size_t)(b * SEQ + i0 + l31) * 1024 + hq * 64 + et * 32 + 8 * g + 4 * hh) =
            (u32x2){cvt_pk_bf16(o[et][4 * g] * inv, o[et][4 * g + 1] * inv), cvt_pk_bf16(o[et][4 * g + 2] * inv, o[et][4 * g + 3] * inv)};
  }
}
__device__ __forceinline__ void phase_gemm_swo(const P& p, LAS unsigned char* lds, int bid, int nb) {
  EpiResid E; E.res = p.out; E.z = (float*)(p.ws + R_Z);
  run_gemm(lds, (const bf16_t*)(p.ws + R_AO), (const bf16_t*)(p.ws + WS_WT_SWO), T, 1024, 1024, E, bid, nb);
}
__global__ __launch_bounds__(512, 2) void mega_fwd(P p) {
  extern __shared__ __attribute__((aligned(16))) unsigned char shm[];
  LAS unsigned char* lds = (LAS unsigned char*)shm;
  cooperative_groups::grid_group grid = cooperative_groups::this_grid();
  const int bid = blockIdx.x, nb = gridDim.x;
  float* hA = (float*)(p.ws + WS_HA); bf16_t* hb = (bf16_t*)(p.ws + WS_HB16); const float* z = (const float*)(p.ws + R_Z);
  phase_prep(p, lds, bid, nb);            grid.sync();
  phase_gemm1(p, lds, bid, nb);           grid.sync();
  phase_hgrn_a(p, lds, bid, nb);          grid.sync();
  phase_hgrn_b(p, bid, nb);               grid.sync();
  phase_hgrn_c(p, bid, nb);               grid.sync();
  phase_gemm2(p, lds, bid, nb);           grid.sync();
  phase_ln(z, p.ln_mix_g, p.ln_mix_b, hA, hb, bid, nb);   grid.sync();
  phase_peer_scores(p, 0, lds, bid, nb);  grid.sync();
  phase_peer_topk(p, bid, nb);            grid.sync();
  phase_peer_gather<8>(p, 0, hA, p.out, bid, nb);         grid.sync();
  phase_gemm_qkv(p, lds, bid, nb);        grid.sync();
  phase_attn(p, bid, nb);                 grid.sync();
  phase_gemm_swo(p, lds, bid, nb);        grid.sync();
  phase_ln(z, p.ln_mix_g + 1024, p.ln_mix_b + 1024, hA, hb, bid, nb);   grid.sync();
  phase_peer_scores(p, 1, lds, bid, nb);  grid.sync();
  phase_peer_topk(p, bid, nb);            grid.sync();
  phase_peer_gather<8>(p, 1, hA, p.out, bid, nb);
}
}

extern "C" void kernel_launch(void* const* d_in, const int* in_sizes, int n_in, void* d_out, int out_size, void* d_ws, size_t ws_size, hipStream_t stream) {
  constexpr int LDSB = 131072;
  static int grid_blocks = 0;
  if (!grid_blocks) {
    int dev = 0, cus = 0, per_cu = 0;
    hipGetDevice(&dev);
    hipDeviceGetAttribute(&cus, hipDeviceAttributeMultiprocessorCount, dev);
    hipFuncSetAttribute((const void*)mk::mega_fwd, hipFuncAttributeMaxDynamicSharedMemorySize, LDSB);
    hipOccupancyMaxActiveBlocksPerMultiprocessor(&per_cu, (const void*)mk::mega_fwd, 512, LDSB);
    if (per_cu < 1) per_cu = 1;
    if (per_cu > 1) per_cu = 1;
    grid_blocks = cus * per_cu;
  }
  mk::P p{};
  p.x = (const float*)d_in[0]; p.pos = (const int*)d_in[1]; p.hg_w_in = (const float*)d_in[2]; p.hg_lb = (const float*)d_in[3]; p.hg_norm_w = (const float*)d_in[4];
  p.hg_w_o = (const float*)d_in[5]; p.sw_w_q = (const float*)d_in[6]; p.sw_sinks = (const float*)d_in[7]; p.sw_w_o = (const float*)d_in[8]; p.w_kv = (const float*)d_in[9];
  p.peer_w_q = (const float*)d_in[10]; p.peer_sk = (const float*)d_in[11]; p.peer_u = (const float*)d_in[12]; p.peer_v = (const float*)d_in[13];
  p.ln_mix_g = (const float*)d_in[14]; p.ln_mix_b = (const float*)d_in[15]; p.ln_ffn_g = (const float*)d_in[16]; p.ln_ffn_b = (const float*)d_in[17];
  p.out = (float*)d_out; p.ws = (unsigned char*)d_ws;
  void* args[] = {&p};
  hipError_t e = hipLaunchCooperativeKernel((const void*)mk::mega_fwd, dim3(grid_blocks), dim3(512), args, LDSB, stream);
  if (e != hipSuccess) fprintf(stderr, "cooperative launch failed: %s (grid %d)\n", hipGetErrorString(e), grid_blocks);
}
```

```cpp
#include <hip/hip_runtime.h>
#include <hip/hip_cooperative_groups.h>
#include <math.h>
#include <cstdio>
namespace pg8 {
#define PG8_LAS __attribute__((address_space(3)))
typedef unsigned short bf16_t;
typedef short bf16x8 __attribute__((ext_vector_type(8)));
typedef float f32x4 __attribute__((ext_vector_type(4)));
typedef unsigned u32x4 __attribute__((ext_vector_type(4)));
constexpr int BM = 256, BK = 64, HALF = 128, HTB = HALF * BK * 2  , STAGE_BYTES = 8 * HTB, NXCD = 8, WGM = 8;

__host__ __device__ __forceinline__ int lds_byte(int r, int c) { const int st = (r >> 4) * 2 + (c >> 5), rr = r & 15, cc = c & 31, ob = rr * 64 + cc * 2; return st * 1024 + (ob ^ (((ob >> 9) & 1) << 5)); }
__host__ __device__ __forceinline__ void stage_rc(int b, int& R, int& C) { const int st = b / 1024, sb = b % 1024, swz = sb ^ (((sb >> 9) & 1) << 5); R = (st >> 1) * 16 + swz / 64; C = (st & 1) * 32 + (swz % 64) / 2; }
__host__ __device__ __forceinline__ int perm32(int rho) { const int n = rho >> 4, i = rho & 15; return 8 * (i >> 2) + 4 * n + (i & 3); }

struct Unit { int pm, pn; };
struct Gemm { const bf16_t* A; const bf16_t* Bt; int M, N, K; };

struct StaticOrder {
    int nM, nN, nwg, G, c;
    __host__ __device__ void init(int M, int N, int G_, int c_) { nM = M / BM; nN = N / BM; nwg = nM * nN; G = G_; c = c_; }
    __host__ __device__ bool next(int i, Unit& u) const {
        const long L = (long)i * G + c; if (L >= nwg) return false;
        int wgid = (int)L; { const int q = nwg / NXCD, r = nwg % NXCD, xcd = wgid % NXCD, off = wgid / NXCD; wgid = (xcd < r ? xcd * (q + 1) : r * (q + 1) + (xcd - r) * q) + off; }
        const int nig = WGM * nN, gid = wgid / nig, fm = gid * WGM, gsz = (nM - fm) < WGM ? (nM - fm) : WGM;
        u.pm = fm + ((wgid % nig) % gsz); u.pn = (wgid % nig) / gsz; return true;
    }
    __device__ __forceinline__ void a_ready(const Unit&) const {}
    __device__ __forceinline__ void done(const Unit&) const {}
};
typedef __bf16 bf16v2_t __attribute__((ext_vector_type(2)));
typedef float f32v2_t __attribute__((ext_vector_type(2)));
__device__ __forceinline__ unsigned cvt_pk_bf16(float lo, float hi) { const f32v2_t v = {lo, hi}; return __builtin_bit_cast(unsigned, __builtin_convertvector(v, bf16v2_t)); }
typedef float f32x2 __attribute__((ext_vector_type(2)));

template <class Epi, class Sched, bool STAMP = false>
__device__ __forceinline__ void gemm_phase(PG8_LAS unsigned char* lds, const Gemm g, const Sched& S, const Epi& E, unsigned long long* stamps) {
    const int tid = threadIdx.x, wid = __builtin_amdgcn_readfirstlane(tid >> 6), lane = tid & 63, wr = wid >> 2, wc = wid & 3, fr = lane & 15, fq = lane >> 4;
    const int K = g.K, nt = K / BK;
    int ts_lo = 0, ts_hi = 0, nts = 0; const unsigned long long rt_entry = STAMP ? (unsigned long long)wall_clock64() : 0ull;
#define PG8_STAMP() do { if (STAMP && wid == 0 && nts < 64) { const unsigned long long _c = (unsigned long long)clock64(); \
        ts_lo = (lane == nts) ? (int)(unsigned)_c : ts_lo; ts_hi = (lane == nts) ? (int)(unsigned)(_c >> 32) : ts_hi; ++nts; } } while (0)
    PG8_STAMP();
    unsigned voffA[2], voffB[2];
#pragma unroll
    for (int i = 0; i < 2; ++i) { int R, C; stage_rc(tid * 16 + i * 8192, R, C); const int Rb = Epi::PERM ? ((R & ~31) + perm32(R & 31)) : R;
        voffA[i] = (unsigned)(R * K + C) * 2u; voffB[i] = (unsigned)(Rb * K + C) * 2u; }
    const size_t kstep = (size_t)(BK * 2);
    const size_t hstep = (size_t)HALF * K * 2;
    const size_t tstep = 2 * hstep;
    const unsigned ldsw = (unsigned)wid * 1024u;
    const int aoff = lds_byte(wr * 64 + fr, fq * 8), boff = lds_byte(wc * 32 + fr, fq * 8);
#define PG8_SA(b, h) (((b) * 2 + (h)) * HTB)
#define PG8_SB(b, h) ((4 + (b) * 2 + (h)) * HTB)
#define PG8_STAGE(bufoff, gbase, voff) do { _Pragma("unroll") for (int _i = 0; _i < 2; ++_i) \
        __builtin_amdgcn_global_load_lds((const unsigned*)((const char*)(gbase) + (voff)[_i]), (PG8_LAS unsigned*)(lds + (bufoff) + ldsw + _i * 8192), 16, 0, 0); } while (0)
#define PG8_LDA(dst, b, h) do { _Pragma("unroll") for (int m = 0; m < 4; ++m) _Pragma("unroll") for (int k = 0; k < 2; ++k) dst[m][k] = *(const PG8_LAS bf16x8*)(lds + PG8_SA(b, h) + aoff + m * 2048 + k * 1024); } while (0)
#define PG8_LDB(dst, b, h) do { _Pragma("unroll") for (int n = 0; n < 2; ++n) _Pragma("unroll") for (int k = 0; k < 2; ++k) dst[n][k] = *(const PG8_LAS bf16x8*)(lds + PG8_SB(b, h) + boff + n * 2048 + k * 1024); } while (0)
#define PG8_MMA(ai, bj, At, Bt) do { __builtin_amdgcn_s_setprio(1); _Pragma("unroll") for (int m = 0; m < 4; ++m) _Pragma("unroll") for (int n = 0; n < 2; ++n) _Pragma("unroll") for (int k = 0; k < 2; ++k) \
        acc[ai][bj][m][n] = __builtin_amdgcn_mfma_f32_16x16x32_bf16(Bt[n][k], At[m][k], acc[ai][bj][m][n], 0, 0, 0); __builtin_amdgcn_s_setprio(0); } while (0)
#define PG8_WAIT_V(n) asm volatile("s_waitcnt vmcnt(" #n ")" ::: "memory")
#define PG8_WAIT_L(n) asm volatile("s_waitcnt lgkmcnt(" #n ")" ::: "memory")
#define PG8_BAR __builtin_amdgcn_s_barrier()
#define PG8_SCHED __builtin_amdgcn_sched_barrier(0)
    Unit cur, nxt; int ui = 0;
    if (!S.next(0, cur)) return;
    f32x4 acc[2][2][4][2];
#pragma unroll
    for (int a = 0; a < 2; ++a)
#pragma unroll
        for (int b = 0; b < 2; ++b)
#pragma unroll
            for (int m = 0; m < 4; ++m)
#pragma unroll
                for (int n = 0; n < 2; ++n) acc[a][b][m][n] = (f32x4){0.f, 0.f, 0.f, 0.f};
    bf16x8 At[4][2], B0[2][2], B1[2][2];
    const char* cA = (const char*)g.A + (size_t)cur.pm * tstep; const char* cB = (const char*)g.Bt + (size_t)cur.pn * tstep;
    S.a_ready(cur);
    PG8_STAGE(PG8_SB(0, 0), cB, voffB); PG8_STAGE(PG8_SA(0, 0), cA, voffA); PG8_STAGE(PG8_SB(0, 1), cB + hstep, voffB); PG8_STAGE(PG8_SA(0, 1), cA + hstep, voffA);
    if (wr == 1) PG8_BAR;
    PG8_WAIT_V(4); PG8_BAR;
    PG8_STAGE(PG8_SB(1, 0), cB + kstep, voffB); PG8_STAGE(PG8_SA(1, 0), cA + kstep, voffA); PG8_STAGE(PG8_SB(1, 1), cB + hstep + kstep, voffB);
    PG8_WAIT_V(6); PG8_BAR;
    PG8_STAMP();
    for (;;) {
        const bool has_next = S.next(ui + 1, nxt);
        const char* nA = has_next ? (const char*)g.A + (size_t)nxt.pm * tstep : cA; const char* nB = has_next ? (const char*)g.Bt + (size_t)nxt.pn * tstep : cB;
        for (int t = 0; t < nt; t += 2) {
            const bool last = (t == nt - 2);
            const char* a1 = cA + (size_t)(t + 1) * kstep;
            const char* a2 = last ? nA : cA + (size_t)(t + 2) * kstep; const char* b2 = last ? nB : cB + (size_t)(t + 2) * kstep;
            const char* a3 = a2 + kstep; const char* b3 = b2 + kstep;
            if (last && has_next) S.a_ready(nxt);
            PG8_LDB(B0, 0, 0); PG8_SCHED; PG8_LDA(At, 0, 0); PG8_STAGE(PG8_SA(1, 1), a1 + hstep, voffA);
            PG8_WAIT_L(8); PG8_BAR; PG8_WAIT_L(0); PG8_MMA(0, 0, At, B0); PG8_BAR; PG8_SCHED;
            PG8_LDB(B1, 0, 1); PG8_STAGE(PG8_SB(0, 0), b2, voffB);
            PG8_BAR; PG8_WAIT_L(0); PG8_MMA(0, 1, At, B1); PG8_BAR;
            PG8_LDA(At, 0, 1); PG8_STAGE(PG8_SA(0, 0), a2, voffA);
            PG8_BAR; PG8_WAIT_L(0); PG8_MMA(1, 0, At, B0); PG8_BAR; PG8_SCHED;
            PG8_STAGE(PG8_SB(0, 1), b2 + hstep, voffB);
            PG8_WAIT_V(6); PG8_BAR; PG8_MMA(1, 1, At, B1); PG8_BAR;
            PG8_LDB(B0, 1, 0); PG8_SCHED; PG8_LDA(At, 1, 0); PG8_STAGE(PG8_SA(0, 1), a2 + hstep, voffA);
            PG8_WAIT_L(8); PG8_BAR; PG8_WAIT_L(0); PG8_MMA(0, 0, At, B0); PG8_BAR; PG8_SCHED;
            PG8_LDB(B1, 1, 1); PG8_STAGE(PG8_SB(1, 0), b3, voffB);
            PG8_BAR; PG8_WAIT_L(0); PG8_MMA(0, 1, At, B1); PG8_BAR;
            PG8_LDA(At, 1, 1); PG8_STAGE(PG8_SA(1, 0), a3, voffA);
            PG8_BAR; PG8_WAIT_L(0); PG8_MMA(1, 0, At, B0); PG8_BAR; PG8_SCHED;
            PG8_STAGE(PG8_SB(1, 1), b3 + hstep, voffB);
            PG8_WAIT_V(6); PG8_BAR; PG8_MMA(1, 1, At, B1); PG8_BAR;
        }
        PG8_STAMP();
        if constexpr (!Epi::AFTER_DRAIN) { E(acc, cur, wr, wc, fr, fq); S.done(cur); }
        PG8_STAMP();
        if (!has_next) break;
#pragma unroll
        for (int a = 0; a < 2; ++a)
#pragma unroll
            for (int b = 0; b < 2; ++b)
#pragma unroll
                for (int m = 0; m < 4; ++m)
#pragma unroll
                    for (int n = 0; n < 2; ++n) acc[a][b][m][n] = (f32x4){0.f, 0.f, 0.f, 0.f};
        cur = nxt; cA = nA; cB = nB; ++ui;
    }
    PG8_WAIT_V(0);
    if (wr == 0) PG8_BAR;
    PG8_BAR;
    if constexpr (Epi::AFTER_DRAIN) { E.fused(acc, cur, wr, wc, fr, fq, lds, wid, lane); S.done(cur); }
    PG8_STAMP();
    if (STAMP && wid == 0) { stamps[lane] = lane < nts ? (((unsigned long long)(unsigned)ts_hi << 32) | (unsigned)ts_lo) : 0ull;
        if (lane == 62) stamps[62] = rt_entry; if (lane == 63) stamps[63] = (unsigned long long)wall_clock64(); }
#undef PG8_STAMP
#undef PG8_SA
#undef PG8_SB
#undef PG8_STAGE
#undef PG8_LDA
#undef PG8_LDB
#undef PG8_MMA
#undef PG8_WAIT_V
#undef PG8_WAIT_L
#undef PG8_BAR
#undef PG8_SCHED
}
}
namespace mk {
using pg8::bf16_t; using pg8::f32x4; using pg8::u32x4; using pg8::bf16x8; using pg8::Unit; using pg8::cvt_pk_bf16;
#define LAS __attribute__((address_space(3)))
typedef unsigned u32x2 __attribute__((ext_vector_type(2)));
typedef float f32x16 __attribute__((ext_vector_type(16)));
constexpr int T = 16384, D = 1024, SEQ = 4096, NTHR = 512;
constexpr float ALPHA = 1.41421356237f;
constexpr size_t MB = (size_t)1 << 20;
constexpr size_t WS_CTL = 0, WS_LBV = 1 * MB, WS_CS = 2 * MB, WS_WT_IN = 4 * MB, WS_WT_O = 12 * MB, WS_WT_QKV = 14 * MB, WS_WT_SWO = 17 * MB, WS_WT_PEER = 19 * MB,
                 WS_TABU = 32 * MB, WS_TABV = 96 * MB, WS_HA = 160 * MB, WS_HB16 = 224 * MB, WS_R3 = 256 * MB;
constexpr size_t R_QS = WS_R3, R_LF = WS_R3 + 32 * MB, R_VI = WS_R3 + 96 * MB, R_GS = WS_R3 + 128 * MB, R_ST = WS_R3 + 160 * MB, R_DEC = WS_R3 + 224 * MB, R_Z = WS_R3 + 160 * MB;
constexpr size_t R_SC = WS_R3, R_EIDX = WS_R3 + 128 * MB, R_GATE = WS_R3 + 136 * MB;
constexpr size_t R_Q = WS_R3, R_KB = WS_R3 + 32 * MB, R_VT = WS_R3 + 40 * MB, R_AO = WS_R3 + 48 * MB;

struct P {
  const float* x; const int* pos; const float *hg_w_in, *hg_lb, *hg_norm_w, *hg_w_o, *sw_w_q, *sw_sinks, *sw_w_o, *w_kv, *peer_w_q, *peer_sk, *peer_u, *peer_v,
      *ln_mix_g, *ln_mix_b, *ln_ffn_g, *ln_ffn_b;
  float* out; unsigned char* ws;
};

__device__ __forceinline__ float bf2f(unsigned short b) { return __uint_as_float(((unsigned)b) << 16); }
__device__ __forceinline__ float bflo(unsigned w) { return __uint_as_float(w << 16); }
__device__ __forceinline__ float bfhi(unsigned w) { return __uint_as_float(w & 0xffff0000u); }
__device__ __forceinline__ float fast_exp(float x) { return __builtin_amdgcn_exp2f(x * 1.44269504089f); }
__device__ __forceinline__ float fast_rcp(float x) { return __builtin_amdgcn_rcpf(x); }
__device__ __forceinline__ float fast_sigmoid(float x) { return fast_rcp(1.0f + fast_exp(-x)); }
__device__ __forceinline__ float fast_silu(float x) { return x * fast_sigmoid(x); }
__device__ __forceinline__ float wave_sum(float v) {
#pragma unroll
  for (int o = 1; o < 64; o <<= 1) v += __shfl_xor(v, o);
  return v;
}
#define XB_TMO      128
#define XB_XCNT(j)  (256  + 64 * (j))
#define XB_XSUB(j)  (1280 + 64 * (j))
#define XB_XGEN(j)  (2304 + 64 * (j))
#define XB_TOP      3328
#define XB_TOPGEN   3392
#define XCD_BAR_WORDS 3456
#define XB_SPIN_CAP (1u << 18)


__device__ __forceinline__ unsigned xb_ld(unsigned* p)              { return __hip_atomic_load(p, __ATOMIC_RELAXED, __HIP_MEMORY_SCOPE_AGENT); }
__device__ __forceinline__ unsigned xb_add(unsigned* p, unsigned v) { return __hip_atomic_fetch_add(p, v, __ATOMIC_RELAXED, __HIP_MEMORY_SCOPE_AGENT); }
__device__ __forceinline__ unsigned xb_xcc_id() { return (unsigned)__builtin_amdgcn_s_getreg((3 << 11) | 20) & 0xFu; }
#define XB_SPIN(cond, bar) do { unsigned _sp = 0; while (cond) { __builtin_amdgcn_s_sleep(1); \
    if ((++_sp & 255u) == 0u) { if (xb_ld(&(bar)[XB_TMO])) break; if (_sp > XB_SPIN_CAP) { atomicAdd(&(bar)[XB_TMO], 1u); break; } } } } while (0)

struct XcdBarrier {
    unsigned* bar; unsigned x;
    volatile LAS unsigned* st;
};

__device__ __forceinline__ XcdBarrier xcd_barrier_post(unsigned* bar, volatile LAS unsigned* st) {
    XcdBarrier b; b.bar = bar; b.x = xb_xcc_id(); b.st = st;
    if (threadIdx.x == 0) (void)xb_add(&bar[XB_XCNT(b.x)], 1u);
    return b;
}
__device__ __forceinline__ void xcd_barrier_complete(unsigned* bar, unsigned x, unsigned& nloc, unsigned& nx) {
    const unsigned G = gridDim.x * gridDim.y * gridDim.z;
    unsigned sum, cnt, mine, sp = 0u;
    for (;;) {
        sum = 0u; cnt = 0u; mine = 0u;
#pragma unroll
        for (unsigned j = 0; j < 16; ++j) { const unsigned c = xb_ld(&bar[XB_XCNT(j)]); sum += c; cnt += (c > 0u) ? 1u : 0u; mine = (j == x) ? c : mine; }
        if (sum == G) break;
        __builtin_amdgcn_s_sleep(1);
        if ((++sp & 255u) == 0u) { if (xb_ld(&bar[XB_TMO])) break; if (sp > XB_SPIN_CAP) { atomicAdd(&bar[XB_TMO], 1u); break; } }
    }
    nloc = mine > 0u ? mine : 1u; nx = cnt > 0u ? cnt : 1u;
}

__device__ __forceinline__ void xcd_barrier(const XcdBarrier& b) {
    asm volatile("s_waitcnt vmcnt(0)" ::: "memory");
    __syncthreads();
    if (threadIdx.x == 0) {
        unsigned* bar = b.bar;
        __builtin_amdgcn_s_waitcnt(0);
        unsigned nloc = b.st[0], nx = b.st[1];
        if (nloc == 0u) { xcd_barrier_complete(bar, b.x, nloc, nx); b.st[0] = nloc; b.st[1] = nx; }
        const unsigned old = xb_add(&bar[XB_XSUB(b.x)], 1u);
        const unsigned gen = old / nloc;
        if (old + 1u == (gen + 1u) * nloc) {
            __builtin_amdgcn_fence(__ATOMIC_RELEASE, "agent");
            asm volatile("s_waitcnt vmcnt(0)" ::: "memory");
            const unsigned og = xb_add(&bar[XB_TOP], 1u);
            const unsigned tg = og / nx;
            if (og + 1u == (tg + 1u) * nx) xb_add(&bar[XB_TOPGEN], 1u);
            else XB_SPIN(xb_ld(&bar[XB_TOPGEN]) == tg, bar);
            __builtin_amdgcn_fence(__ATOMIC_ACQUIRE, "agent");
            xb_add(&bar[XB_XGEN(b.x)], 1u);
            asm volatile("s_waitcnt vmcnt(0)" ::: "memory");
        } else {
            XB_SPIN(xb_ld(&bar[XB_XGEN(b.x)]) == gen, bar);
            __builtin_amdgcn_fence(__ATOMIC_ACQUIRE, "agent");
            asm volatile("s_waitcnt vmcnt(0)" ::: "memory");
        }
    }
    __syncthreads();
}
__device__ __forceinline__ void cvt_stream(const float* __restrict__ src, bf16_t* __restrict__ dst, size_t n, size_t gtid, size_t gthreads) {
  const size_t n8 = n >> 3;
  for (size_t i = gtid; i < n8; i += gthreads) {
    const f32x4 a = ((const f32x4*)src)[2 * i], b = ((const f32x4*)src)[2 * i + 1];
    u32x4 o; o.x = cvt_pk_bf16(a.x, a.y); o.y = cvt_pk_bf16(a.z, a.w); o.z = cvt_pk_bf16(b.x, b.y); o.w = cvt_pk_bf16(b.z, b.w);
    ((u32x4*)dst)[i] = o;
  }
}
__device__ __forceinline__ void transpose_tile(const float* __restrict__ W, int K, int N, bf16_t* __restrict__ Wt, int row_off, int tile, LAS float* scr, int tid) {
  const int ntn = N / 64, kb = tile / ntn, nbk = tile % ntn, k0 = kb * 64, n0 = nbk * 64;
  { const int k = tid >> 3, n8 = (tid & 7) * 8;
    const f32x4 a = *(const f32x4*)(W + (size_t)(k0 + k) * N + n0 + n8), b = *(const f32x4*)(W + (size_t)(k0 + k) * N + n0 + n8 + 4);
    LAS float* s = scr + k * 65 + n8; s[0] = a.x; s[1] = a.y; s[2] = a.z; s[3] = a.w; s[4] = b.x; s[5] = b.y; s[6] = b.z; s[7] = b.w; }
  __syncthreads();
  { const int n = tid >> 3, k8 = (tid & 7) * 8; const LAS float* s = scr + k8 * 65 + n;
    u32x4 o; o.x = cvt_pk_bf16(s[0], s[65]); o.y = cvt_pk_bf16(s[130], s[195]); o.z = cvt_pk_bf16(s[260], s[325]); o.w = cvt_pk_bf16(s[390], s[455]);
    *(u32x4*)(Wt + (size_t)(row_off + n0 + n) * K + k0 + k8) = o; }
  __syncthreads();
}
__device__ __forceinline__ void peer_fold_item(const P& p, int item, LAS float* lds, int tid) {
  const int kt = item & 15, hc = (item >> 4) & 15, l = item >> 8, k0 = kt * 64;
  LAS float* sks = lds;
  LAS float* wqs = lds + 128 * 132;
  const float* SK = p.peer_sk + ((size_t)l * 16 + hc) * 128 * 128;
  const float* WQ = p.peer_w_q + (size_t)l * 1024 * 2048 + hc * 128;
  { const int key = tid & 127, dq = tid >> 7;
#pragma unroll
    for (int j = 0; j < 8; ++j) { const int d4 = (dq + 4 * j) * 4; const f32x4 v = *(const f32x4*)(SK + key * 128 + d4);
      sks[(d4 + 0) * 132 + key] = v.x; sks[(d4 + 1) * 132 + key] = v.y; sks[(d4 + 2) * 132 + key] = v.z; sks[(d4 + 3) * 132 + key] = v.w; } }
  { const int k = tid & 63, dq = tid >> 6;
#pragma unroll
    for (int j = 0; j < 4; ++j) { const int d4 = (dq + 8 * j) * 4; const f32x4 v = *(const f32x4*)(WQ + (size_t)(k0 + k) * 2048 + d4);
      wqs[(d4 + 0) * 68 + k] = v.x; wqs[(d4 + 1) * 68 + k] = v.y; wqs[(d4 + 2) * 68 + k] = v.z; wqs[(d4 + 3) * 68 + k] = v.w; } }
  __syncthreads();
  const int kq = tid & 15, keyq = tid >> 4;
  float acc[4][4];
#pragma unroll
  for (int i = 0; i < 4; ++i)
#pragma unroll
    for (int j = 0; j < 4; ++j) acc[i][j] = 0.f;
#pragma unroll 4
  for (int d = 0; d < 128; ++d) {
    const f32x4 a = *(const LAS f32x4*)(sks + d * 132 + keyq * 4), b = *(const LAS f32x4*)(wqs + d * 68 + kq * 4);
    const float av[4] = {a.x, a.y, a.z, a.w}, bv[4] = {b.x, b.y, b.z, b.w};
#pragma unroll
    for (int i = 0; i < 4; ++i)
#pragma unroll
      for (int j = 0; j < 4; ++j) acc[i][j] += av[i] * bv[j];
  }
  bf16_t* Wt = (bf16_t*)(p.ws + WS_WT_PEER) + ((size_t)l * 2048 + hc * 128) * 1024;
#pragma unroll
  for (int i = 0; i < 4; ++i) { u32x2 o; o.x = cvt_pk_bf16(acc[i][0], acc[i][1]); o.y = cvt_pk_bf16(acc[i][2], acc[i][3]);
    *(u32x2*)(Wt + (size_t)(keyq * 4 + i) * 1024 + k0 + kq * 4) = o; }
  __syncthreads();
}
__device__ __forceinline__ void phase_prep(const P& p, LAS unsigned char* lds, int bid, int nb) {
  const int tid = threadIdx.x; const size_t gtid = (size_t)bid * NTHR + tid, gth = (size_t)nb * NTHR;
  if (gtid < 1024) { const float a0 = p.hg_lb[gtid], a1 = p.hg_lb[1024 + gtid], mx = fmaxf(a0, a1), e0 = expf(a0 - mx), e1 = expf(a1 - mx); ((float*)(p.ws + WS_LBV))[gtid] = e0 / (e0 + e1); }
  for (size_t i = gtid; i < (size_t)T * 8; i += gth) { const int t = (int)(i >> 3), j = (int)(i & 7);
    const double inv = pow(500000.0, -(double)(2 * j) / 16.0), ang = (double)p.pos[t] * inv;
    ((float2*)(p.ws + WS_CS))[i] = make_float2((float)cos(ang), (float)sin(ang)); }
  LAS float* scr = (LAS float*)lds;
  constexpr int T_IN = 16 * 64, T_O = 16 * 16, T_Q = 16 * 16, T_KV = 16 * 8, T_SWO = 16 * 16, NT_ALL = T_IN + T_O + T_Q + T_KV + T_SWO;
  for (int it = bid; it < NT_ALL; it += nb) {
    int r = it;
    if (r < T_IN) { transpose_tile(p.hg_w_in, 1024, 4096, (bf16_t*)(p.ws + WS_WT_IN), 0, r, scr, tid); continue; } r -= T_IN;
    if (r < T_O) { transpose_tile(p.hg_w_o, 1024, 1024, (bf16_t*)(p.ws + WS_WT_O), 0, r, scr, tid); continue; } r -= T_O;
    if (r < T_Q) { transpose_tile(p.sw_w_q, 1024, 1024, (bf16_t*)(p.ws + WS_WT_QKV), 0, r, scr, tid); continue; } r -= T_Q;
    if (r < T_KV) { transpose_tile(p.w_kv, 1024, 512, (bf16_t*)(p.ws + WS_WT_QKV), 1024, r, scr, tid); continue; } r -= T_KV;
    transpose_tile(p.sw_w_o, 1024, 1024, (bf16_t*)(p.ws + WS_WT_SWO), 0, r, scr, tid);
  }
  for (int it = bid; it < 512; it += nb) peer_fold_item(p, it, scr, tid);
  cvt_stream(p.x, (bf16_t*)(p.ws + WS_HB16), (size_t)T * D, gtid, gth);
  cvt_stream(p.peer_u, (bf16_t*)(p.ws + WS_TABU), (size_t)2 * 16384 * 1024, gtid, gth);
  cvt_stream(p.peer_v, (bf16_t*)(p.ws + WS_TABV), (size_t)2 * 16384 * 1024, gtid, gth);
}
struct EpiHgrn {
  static constexpr bool PERM = true, AFTER_DRAIN = false;
  unsigned char* ws; float* lf; const float* lbv;
  __device__ __forceinline__ void operator()(const f32x4 (&acc)[2][2][4][2], const Unit& u, int wr, int wc, int fr, int fq) const {
    const int sec = u.pn >> 2, row0 = u.pm * 256 + wr * 64 + fr, col0 = (u.pn & 3) * 256 + wc * 32 + 8 * fq;
    if (sec == 1) {
      float lb[2][8];
#pragma unroll
      for (int bj = 0; bj < 2; ++bj) { const f32x4 a = *(const f32x4*)(lbv + col0 + bj * 128), b = *(const f32x4*)(lbv + col0 + bj * 128 + 4);
        lb[bj][0] = a.x; lb[bj][1] = a.y; lb[bj][2] = a.z; lb[bj][3] = a.w; lb[bj][4] = b.x; lb[bj][5] = b.y; lb[bj][6] = b.z; lb[bj][7] = b.w; }
#pragma unroll
      for (int ai = 0; ai < 2; ++ai)
#pragma unroll
        for (int m = 0; m < 4; ++m) { float* rowp = lf + (size_t)(row0 + ai * 128 + m * 16) * 1024 + col0;
#pragma unroll
          for (int bj = 0; bj < 2; ++bj) { f32x4 o[2];
#pragma unroll
            for (int n = 0; n < 2; ++n)
#pragma unroll
              for (int j = 0; j < 4; ++j) { const float l = lb[bj][4 * n + j]; o[n][j] = __logf(l + (1.0f - l) * fast_sigmoid(acc[ai][bj][m][n][j])); }
            *(f32x4*)(rowp + bj * 128) = o[0]; *(f32x4*)(rowp + bj * 128 + 4) = o[1]; } }
    } else {
      const size_t doff = sec == 0 ? R_QS : (sec == 2 ? R_VI : R_GS);
      bf16_t* dst = (bf16_t*)(ws + doff);
#pragma unroll
      for (int ai = 0; ai < 2; ++ai)
#pragma unroll
        for (int m = 0; m < 4; ++m) { bf16_t* rowp = dst + (size_t)(row0 + ai * 128 + m * 16) * 1024 + col0;
#pragma unroll
          for (int bj = 0; bj < 2; ++bj) { f32x4 v0 = acc[ai][bj][m][0], v1 = acc[ai][bj][m][1];
            if (sec != 2) {
#pragma unroll
              for (int j = 0; j < 4; ++j) { v0[j] = fast_silu(v0[j]); v1[j] = fast_silu(v1[j]); } }
            u32x4 w; w.x = cvt_pk_bf16(v0[0], v0[1]); w.y = cvt_pk_bf16(v0[2], v0[3]); w.z = cvt_pk_bf16(v1[0], v1[1]); w.w = cvt_pk_bf16(v1[2], v1[3]);
            *(u32x4*)(rowp + bj * 128) = w; } }
    }
  }
};
struct EpiResid {
  static constexpr bool PERM = false, AFTER_DRAIN = false;
  const float* res; float* z;
  __device__ __forceinline__ void operator()(const f32x4 (&acc)[2][2][4][2], const Unit& u, int wr, int wc, int fr, int fq) const {
    const int row0 = u.pm * 256 + wr * 64 + fr, col0 = u.pn * 256 + wc * 32 + 4 * fq;
#pragma unroll
    for (int ai = 0; ai < 2; ++ai)
#pragma unroll
      for (int m = 0; m < 4; ++m) { const size_t off = (size_t)(row0 + ai * 128 + m * 16) * 1024 + col0;
#pragma unroll
        for (int bj = 0; bj < 2; ++bj)
#pragma unroll
          for (int n = 0; n < 2; ++n) { const f32x4 r = *(const f32x4*)(res + off + bj * 128 + n * 16); *(f32x4*)(z + off + bj * 128 + n * 16) = acc[ai][bj][m][n] + ALPHA * r; } }
  }
};
struct EpiF32 {
  static constexpr bool PERM = false, AFTER_DRAIN = false;
  float* C; int ldc;
  __device__ __forceinline__ void operator()(const f32x4 (&acc)[2][2][4][2], const Unit& u, int wr, int wc, int fr, int fq) const {
    const int row0 = u.pm * 256 + wr * 64 + fr, col0 = u.pn * 256 + wc * 32 + 4 * fq;
#pragma unroll
    for (int ai = 0; ai < 2; ++ai)
#pragma unroll
      for (int m = 0; m < 4; ++m) { float* rowp = C + (size_t)(row0 + ai * 128 + m * 16) * ldc + col0;
#pragma unroll
        for (int bj = 0; bj < 2; ++bj)
#pragma unroll
          for (int n = 0; n < 2; ++n) *(f32x4*)(rowp + bj * 128 + n * 16) = acc[ai][bj][m][n]; }
  }
};

template <class Epi>
__device__ __forceinline__ void run_gemm(LAS unsigned char* lds, const bf16_t* A, const bf16_t* Bt, int M, int N, int K, const Epi& E, int bid, int nb) {
  pg8::Gemm g; g.A = A; g.Bt = Bt; g.M = M; g.N = N; g.K = K;
  pg8::StaticOrder S; S.init(M, N, nb, bid);
  pg8::gemm_phase<Epi, pg8::StaticOrder, false>(lds, g, S, E, nullptr);
}
__device__ __forceinline__ void phase_gemm1(const P& p, LAS unsigned char* lds, int bid, int nb) {
  EpiHgrn E; E.ws = p.ws; E.lf = (float*)(p.ws + R_LF); E.lbv = (const float*)(p.ws + WS_LBV);
  run_gemm(lds, (const bf16_t*)(p.ws + WS_HB16), (const bf16_t*)(p.ws + WS_WT_IN), T, 4096, 1024, E, bid, nb);
}
#define MFMA32(a, b, c) __builtin_amdgcn_mfma_f32_32x32x16_bf16((a), (b), (c), 0, 0, 0)
constexpr int A_QD = 0, A_KD = 17408, A_KLT = 34816, A_VT = 53248, A_P = 71680, A_TOT = 80896;
__device__ __forceinline__ void phase_hgrn_a(const P& p, LAS unsigned char* lds, int bid, int nb) {
  const int tid = threadIdx.x, lane = tid & 63, wid = __builtin_amdgcn_readfirstlane(tid >> 6), l31 = lane & 31, hh = lane >> 5;
  LAS bf16_t* qdL = (LAS bf16_t*)(lds + A_QD); LAS bf16_t* kdL = (LAS bf16_t*)(lds + A_KD); LAS bf16_t* klT = (LAS bf16_t*)(lds + A_KLT);
  LAS bf16_t* vT = (LAS bf16_t*)(lds + A_VT); LAS bf16_t* PL = (LAS bf16_t*)(lds + A_P); LAS float* tot = (LAS float*)(lds + A_TOT);
  bf16_t* qs = (bf16_t*)(p.ws + R_QS); const float* lf = (const float*)(p.ws + R_LF); bf16_t* vi = (bf16_t*)(p.ws + R_VI);
  bf16_t* ST = (bf16_t*)(p.ws + R_ST); float* decs = (float*)(p.ws + R_DEC);
  const int d = tid & 127, rg = tid >> 7;
  for (int ch = bid; ch < 2048; ch += nb) {
    const int n = ch & 63, h = (ch >> 6) & 7, b = ch >> 9;
    const size_t t0 = (size_t)b * SEQ + n * 64;
    const size_t g0 = (t0 + rg * 16) * 1024 + h * 128 + d;
    float lfv[16], qv[16], vv[16];
#pragma unroll
    for (int r = 0; r < 16; ++r) { lfv[r] = lf[g0 + (size_t)r * 1024]; qv[r] = bf2f(qs[g0 + (size_t)r * 1024]); vv[r] = bf2f(vi[g0 + (size_t)r * 1024]); }
    float bl[16]; float run = 0.f;
#pragma unroll
    for (int r = 0; r < 16; ++r) { run += lfv[r]; bl[r] = run; }
    tot[rg * 128 + d] = run;
    __syncthreads();
    float off = 0.f, total = 0.f;
#pragma unroll
    for (int g = 0; g < 4; ++g) { const float tg = tot[g * 128 + d]; off += (g < rg) ? tg : 0.f; total += tg; }
    unsigned klp[8], vtp[8];
#pragma unroll
    for (int r = 0; r < 16; r += 2) {
      float qd2[2], kd2[2], kl2[2];
#pragma unroll
      for (int u = 0; u < 2; ++u) { const float bb = off + bl[r + u], k = 1.0f - fast_exp(lfv[r + u]);
        qd2[u] = qv[r + u] * fast_exp(bb); kd2[u] = k * fast_exp(-bb); kl2[u] = k * fast_exp(total - bb); }
      const unsigned qq = cvt_pk_bf16(qd2[0], qd2[1]), kk = cvt_pk_bf16(kd2[0], kd2[1]);
      qdL[(rg * 16 + r) * 136 + d] = (bf16_t)(qq & 0xffffu); qdL[(rg * 16 + r + 1) * 136 + d] = (bf16_t)(qq >> 16);
      kdL[(rg * 16 + r) * 136 + d] = (bf16_t)(kk & 0xffffu); kdL[(rg * 16 + r + 1) * 136 + d] = (bf16_t)(kk >> 16);
      qs[g0 + (size_t)r * 1024] = (bf16_t)(qq & 0xffffu); qs[g0 + (size_t)(r + 1) * 1024] = (bf16_t)(qq >> 16);
      klp[r >> 1] = cvt_pk_bf16(kl2[0], kl2[1]); vtp[r >> 1] = cvt_pk_bf16(vv[r], vv[r + 1]);
    }
    *(LAS u32x4*)(klT + d * 72 + rg * 16) = (u32x4){klp[0], klp[1], klp[2], klp[3]}; *(LAS u32x4*)(klT + d * 72 + rg * 16 + 8) = (u32x4){klp[4], klp[5], klp[6], klp[7]};
    *(LAS u32x4*)(vT + d * 72 + rg * 16) = (u32x4){vtp[0], vtp[1], vtp[2], vtp[3]}; *(LAS u32x4*)(vT + d * 72 + rg * 16 + 8) = (u32x4){vtp[4], vtp[5], vtp[6], vtp[7]};
    if (rg == 0) decs[(size_t)ch * 128 + d] = fast_exp(total);
    __syncthreads();
    if (wid < 3) {
      const int jt = (wid == 2) ? 1 : 0, it = (wid == 0) ? 0 : 1;
      f32x16 c; for (int i = 0; i < 16; ++i) c[i] = 0.f;
#pragma unroll
      for (int ks = 0; ks < 8; ++ks) { const bf16x8 a = *(const LAS bf16x8*)(kdL + (jt * 32 + l31) * 136 + ks * 16 + hh * 8), bq = *(const LAS bf16x8*)(qdL + (it * 32 + l31) * 136 + ks * 16 + hh * 8);
        c = MFMA32(a, bq, c); }
      const int i = it * 32 + l31;
#pragma unroll
      for (int g = 0; g < 4; ++g) { const int j0 = jt * 32 + 8 * g + 4 * hh; float v[4];
#pragma unroll
        for (int u = 0; u < 4; ++u) v[u] = (j0 + u <= i) ? c[4 * g + u] : 0.f;
        *(LAS u32x2*)(PL + i * 72 + j0) = (u32x2){cvt_pk_bf16(v[0], v[1]), cvt_pk_bf16(v[2], v[3])}; }
    }
    { const int tbase = (wid >= 3) ? (wid - 3) * 2 : 10 + wid * 2;
#pragma unroll
      for (int tt = 0; tt < 2; ++tt) { const int tile = tbase + tt, et = tile >> 2, dt = tile & 3;
        f32x16 c; for (int i = 0; i < 16; ++i) c[i] = 0.f;
#pragma unroll
        for (int ks = 0; ks < 4; ++ks) { const bf16x8 a = *(const LAS bf16x8*)(vT + (et * 32 + l31) * 72 + ks * 16 + hh * 8), bk = *(const LAS bf16x8*)(klT + (dt * 32 + l31) * 72 + ks * 16 + hh * 8);
          c = MFMA32(a, bk, c); }
        bf16_t* dst = ST + ((size_t)ch * 128 + et * 32 + 4 * hh) * 128 + dt * 32 + l31;
#pragma unroll
        for (int g = 0; g < 4; ++g)
#pragma unroll
          for (int u = 0; u < 4; u += 2) { const unsigned w = cvt_pk_bf16(c[4 * g + u], c[4 * g + u + 1]);
            dst[(size_t)(8 * g + u) * 128] = (bf16_t)(w & 0xffffu); dst[(size_t)(8 * g + u + 1) * 128] = (bf16_t)(w >> 16); } }
    }
    __syncthreads();
    { const int it = wid >> 2, et = wid & 3;
      f32x16 c; for (int i = 0; i < 16; ++i) c[i] = 0.f;
#pragma unroll
      for (int ks = 0; ks < 4; ++ks) if (ks < 2 + 2 * it) { const bf16x8 a = *(const LAS bf16x8*)(PL + (it * 32 + l31) * 72 + ks * 16 + hh * 8), bv = *(const LAS bf16x8*)(vT + (et * 32 + l31) * 72 + ks * 16 + hh * 8);
        c = MFMA32(a, bv, c); }
      bf16_t* dst = vi + (t0 + it * 32 + 4 * hh) * 1024 + h * 128 + et * 32 + l31;
#pragma unroll
      for (int g = 0; g < 4; ++g)
#pragma unroll
        for (int u = 0; u < 4; u += 2) { const unsigned w = cvt_pk_bf16(c[4 * g + u], c[4 * g + u + 1]);
          dst[(size_t)(8 * g + u) * 1024] = (bf16_t)(w & 0xffffu); dst[(size_t)(8 * g + u + 1) * 1024] = (bf16_t)(w >> 16); }
    }
  }
}
__device__ __forceinline__ void phase_hgrn_b(const P& p, int bid, int nb) {
  bf16_t* ST = (bf16_t*)(p.ws + R_ST); const float* decs = (const float*)(p.ws + R_DEC);
  for (size_t it = (size_t)bid * NTHR + threadIdx.x; it < 131072; it += (size_t)nb * NTHR) {
    const int bh = (int)(it >> 12), quad = (int)(it & 4095), d4 = (quad & 31) * 4;
    bf16_t* base = ST + (size_t)bh * 64 * 16384 + quad * 4; const float* dbase = decs + (size_t)bh * 64 * 128 + d4;
    float s0 = 0.f, s1 = 0.f, s2 = 0.f, s3 = 0.f;
#pragma unroll 8
    for (int n = 0; n < 64; ++n) {
      const u32x2 loc = *(const u32x2*)(base + (size_t)n * 16384); const f32x4 dc = *(const f32x4*)(dbase + n * 128);
      *(u32x2*)(base + (size_t)n * 16384) = (u32x2){cvt_pk_bf16(s0, s1), cvt_pk_bf16(s2, s3)};
      s0 = s0 * dc.x + bflo(loc.x); s1 = s1 * dc.y + bfhi(loc.x); s2 = s2 * dc.z + bflo(loc.y); s3 = s3 * dc.w + bfhi(loc.y);
    }
  }
}
__device__ __forceinline__ void phase_hgrn_c(const P& p, int bid, int nb) {
  const int tid = threadIdx.x, lane = tid & 63, wid = tid >> 6, l31 = lane & 31, hh = lane >> 5;
  const bf16_t* qd = (const bf16_t*)(p.ws + R_QS); bf16_t* oi = (bf16_t*)(p.ws + R_VI); const bf16_t* gs = (const bf16_t*)(p.ws + R_GS); const bf16_t* ST = (const bf16_t*)(p.ws + R_ST);
  for (int wt = bid * 8 + wid; wt < 4096; wt += nb * 8) {
    const int ch = wt >> 1, half = wt & 1, n = ch & 63, h = (ch >> 6) & 7, b = ch >> 9;
    const size_t trow = ((size_t)b * SEQ + n * 64 + half * 32 + l31) * 1024 + h * 128;
    bf16x8 bq[8];
#pragma unroll
    for (int ks = 0; ks < 8; ++ks) bq[ks] = *(const bf16x8*)(qd + trow + ks * 16 + hh * 8);
    f32x16 acc[4];
#pragma unroll
    for (int et = 0; et < 4; ++et) {
      for (int i = 0; i < 16; ++i) acc[et][i] = 0.f;
      const bf16_t* ap = ST + ((size_t)ch * 128 + et * 32 + l31) * 128 + hh * 8;
#pragma unroll
      for (int ks = 0; ks < 8; ++ks) { const bf16x8 a = *(const bf16x8*)(ap + ks * 16); acc[et] = MFMA32(a, bq[ks], acc[et]); }
    }
    float ss = 0.f;
#pragma unroll
    for (int et = 0; et < 4; ++et)
#pragma unroll
      for (int g = 0; g < 4; ++g) { const u32x2 w = *(const u32x2*)(oi + trow + et * 32 + 8 * g + 4 * hh);
        acc[et][4 * g] += bflo(w.x); acc[et][4 * g + 1] += bfhi(w.x); acc[et][4 * g + 2] += bflo(w.y); acc[et][4 * g + 3] += bfhi(w.y);
        ss += acc[et][4 * g] * acc[et][4 * g] + acc[et][4 * g + 1] * acc[et][4 * g + 1] + acc[et][4 * g + 2] * acc[et][4 * g + 2] + acc[et][4 * g + 3] * acc[et][4 * g + 3]; }
    ss += __shfl_xor(ss, 32);
    const float r = rsqrtf(ss * (1.0f / 128.0f) + 1e-6f);
#pragma unroll
    for (int et = 0; et < 4; ++et)
#pragma unroll
      for (int g = 0; g < 4; ++g) { const int e0 = et * 32 + 8 * g + 4 * hh; const f32x4 nw = *(const f32x4*)(p.hg_norm_w + h * 128 + e0); const u32x2 gw = *(const u32x2*)(gs + trow + e0);
        const float o0 = acc[et][4 * g] * r * nw.x * bflo(gw.x), o1 = acc[et][4 * g + 1] * r * nw.y * bfhi(gw.x), o2 = acc[et][4 * g + 2] * r * nw.z * bflo(gw.y), o3 = acc[et][4 * g + 3] * r * nw.w * bfhi(gw.y);
        *(u32x2*)(oi + trow + e0) = (u32x2){cvt_pk_bf16(o0, o1), cvt_pk_bf16(o2, o3)}; }
  }
}
__device__ __forceinline__ void phase_gemm2(const P& p, LAS unsigned char* lds, int bid, int nb) {
  EpiResid E; E.res = p.x; E.z = (float*)(p.ws + R_Z);
  run_gemm(lds, (const bf16_t*)(p.ws + R_VI), (const bf16_t*)(p.ws + WS_WT_O), T, 1024, 1024, E, bid, nb);
}
__device__ __forceinline__ void phase_ln(const float* __restrict__ z, const float* __restrict__ g, const float* __restrict__ bb, float* __restrict__ hout, bf16_t* __restrict__ hb, int bid, int nb) {
  const int lane = threadIdx.x & 63, wid = threadIdx.x >> 6;
  for (int t = bid * 8 + wid; t < T; t += nb * 8) {
    f32x4 v[4]; float s = 0.f;
#pragma unroll
    for (int r = 0; r < 4; ++r) { v[r] = *(const f32x4*)(z + (size_t)t * 1024 + r * 256 + lane * 4); s += (v[r].x + v[r].y) + (v[r].z + v[r].w); }
    const float mu = wave_sum(s) * (1.0f / 1024.0f); float q = 0.f;
#pragma unroll
    for (int r = 0; r < 4; ++r) { v[r] = v[r] - mu; q += (v[r].x * v[r].x + v[r].y * v[r].y) + (v[r].z * v[r].z + v[r].w * v[r].w); }
    const float rs = rsqrtf(wave_sum(q) * (1.0f / 1024.0f) + 1e-5f);
#pragma unroll
    for (int r = 0; r < 4; ++r) { const int c = r * 256 + lane * 4; const f32x4 gg = *(const f32x4*)(g + c), b4 = *(const f32x4*)(bb + c);
      const f32x4 o = v[r] * rs * gg + b4;
      *(f32x4*)(hout + (size_t)t * 1024 + c) = o;
      *(u32x2*)(hb + (size_t)t * 1024 + c) = (u32x2){cvt_pk_bf16(o.x, o.y), cvt_pk_bf16(o.z, o.w)}; }
  }
}
typedef __bf16 bf16x2_t __attribute__((ext_vector_type(2)));
__device__ __forceinline__ float dot2bf(unsigned a, unsigned b, float c) { return __builtin_amdgcn_fdot2_f32_bf16(__builtin_bit_cast(bf16x2_t, a), __builtin_bit_cast(bf16x2_t, b), c, false); }
__device__ __forceinline__ void phase_peer_scores(const P& p, int l, LAS unsigned char* lds, int bid, int nb) {
  EpiF32 E; E.C = (float*)(p.ws + R_SC); E.ldc = 2048;
  run_gemm(lds, (const bf16_t*)(p.ws + WS_HB16), (const bf16_t*)(p.ws + WS_WT_PEER) + (size_t)l * 2048 * 1024, T, 2048, 1024, E, bid, nb);
}
__device__ __forceinline__ void ins16(float (&val)[16], int (&idx)[16], float x, int i) {
  if (x > val[15]) {
    val[15] = x; idx[15] = i;
#pragma unroll
    for (int j = 15; j >= 1; --j) {
      const bool sw = val[j] > val[j - 1];
      const float va = val[j], vb = val[j - 1]; const int ia = idx[j], ib = idx[j - 1];
      val[j] = sw ? vb : va; val[j - 1] = sw ? va : vb; idx[j] = sw ? ib : ia; idx[j - 1] = sw ? ia : ib;
    }
  }
}
__device__ __forceinline__ void phase_peer_topk(const P& p, int bid, int nb) {
  const float* sc = (const float*)(p.ws + R_SC); int* eidx = (int*)(p.ws + R_EIDX); float* gate = (float*)(p.ws + R_GATE);
  for (size_t gi = (size_t)bid * NTHR + threadIdx.x; gi < (size_t)T * 8; gi += (size_t)nb * NTHR) {
    const float* q = sc + gi * 256;
    float v1[16], v2[16], vc[16]; int i1[16], i2[16], ic[16];
#pragma unroll
    for (int j = 0; j < 16; ++j) { v1[j] = -INFINITY; v2[j] = -INFINITY; vc[j] = -INFINITY; i1[j] = 0; i2[j] = 0; ic[j] = 0; }
    for (int i = 0; i < 128; i += 4) { const f32x4 a = *(const f32x4*)(q + i); ins16(v1, i1, a.x, i); ins16(v1, i1, a.y, i + 1); ins16(v1, i1, a.z, i + 2); ins16(v1, i1, a.w, i + 3); }
    for (int i = 0; i < 128; i += 4) { const f32x4 a = *(const f32x4*)(q + 128 + i); ins16(v2, i2, a.x, i); ins16(v2, i2, a.y, i + 1); ins16(v2, i2, a.z, i + 2); ins16(v2, i2, a.w, i + 3); }
#pragma unroll
    for (int a = 0; a < 16; ++a)
#pragma unroll
      for (int b = 0; b < 16; ++b) if ((a + 1) * (b + 1) <= 16) ins16(vc, ic, v1[a] + v2[b], i1[a] * 128 + i2[b]);
    float s = 0.f; float e[16];
#pragma unroll
    for (int j = 0; j < 16; ++j) { e[j] = fast_exp(vc[j] - vc[0]); s += e[j]; }
    const float inv = 1.0f / s;
#pragma unroll
    for (int j = 0; j < 16; j += 4) { *(int4*)(eidx + gi * 16 + j) = make_int4(ic[j], ic[j + 1], ic[j + 2], ic[j + 3]); *(f32x4*)(gate + gi * 16 + j) = (f32x4){e[j] * inv, e[j + 1] * inv, e[j + 2] * inv, e[j + 3] * inv}; }
  }
}
template <int NBATCH>
__device__ __forceinline__ void phase_peer_gather(const P& p, int l, const float* __restrict__ hin, float* __restrict__ hout, int bid, int nb) {
  const int lane = threadIdx.x & 63, wid = threadIdx.x >> 6;
  const int* eidx = (const int*)(p.ws + R_EIDX); const float* gate = (const float*)(p.ws + R_GATE);
  const bf16_t* tabu = (const bf16_t*)(p.ws + WS_TABU) + (size_t)l * 16384 * 1024; const bf16_t* tabv = (const bf16_t*)(p.ws + WS_TABV) + (size_t)l * 16384 * 1024;
  const float* g = p.ln_ffn_g + l * 1024; const float* bb = p.ln_ffn_b + l * 1024; bf16_t* hb = (bf16_t*)(p.ws + WS_HB16);
  for (int t = bid * 8 + wid; t < T; t += nb * 8) {
    float x[16];
    { const f32x4 a0 = *(const f32x4*)(hin + (size_t)t * 1024 + lane * 8), a1 = *(const f32x4*)(hin + (size_t)t * 1024 + lane * 8 + 4),
                  a2 = *(const f32x4*)(hin + (size_t)t * 1024 + 512 + lane * 8), a3 = *(const f32x4*)(hin + (size_t)t * 1024 + 512 + lane * 8 + 4);
      x[0] = a0.x; x[1] = a0.y; x[2] = a0.z; x[3] = a0.w; x[4] = a1.x; x[5] = a1.y; x[6] = a1.z; x[7] = a1.w;
      x[8] = a2.x; x[9] = a2.y; x[10] = a2.z; x[11] = a2.w; x[12] = a3.x; x[13] = a3.y; x[14] = a3.z; x[15] = a3.w; }
    unsigned xb[8];
#pragma unroll
    for (int i = 0; i < 8; ++i) xb[i] = cvt_pk_bf16(x[2 * i], x[2 * i + 1]);
    const int id0 = eidx[(size_t)t * 128 + lane], id1 = eidx[(size_t)t * 128 + 64 + lane];
    const float gt0 = gate[(size_t)t * 128 + lane], gt1 = gate[(size_t)t * 128 + 64 + lane];
    float acc[16];
#pragma unroll
    for (int i = 0; i < 16; ++i) acc[i] = 0.f;
    for (int p0 = 0; p0 < 128; p0 += NBATCH) {
      u32x4 ur[NBATCH][2], vr[NBATCH][2];
#pragma unroll
      for (int k = 0; k < NBATCH; ++k) { const int pp = p0 + k; const int e = __builtin_amdgcn_readlane(pp < 64 ? id0 : id1, pp & 63);
        const bf16_t* up = tabu + (size_t)e * 1024 + lane * 8; const bf16_t* vp = tabv + (size_t)e * 1024 + lane * 8;
        ur[k][0] = *(const u32x4*)up; ur[k][1] = *(const u32x4*)(up + 512); vr[k][0] = *(const u32x4*)vp; vr[k][1] = *(const u32x4*)(vp + 512); }
#pragma unroll
      for (int k = 0; k < NBATCH; ++k) { const int pp = p0 + k;
        float d = 0.f;
        d = dot2bf(ur[k][0].x, xb[0], d); d = dot2bf(ur[k][0].y, xb[1], d); d = dot2bf(ur[k][0].z, xb[2], d); d = dot2bf(ur[k][0].w, xb[3], d);
        d = dot2bf(ur[k][1].x, xb[4], d); d = dot2bf(ur[k][1].y, xb[5], d); d = dot2bf(ur[k][1].z, xb[6], d); d = dot2bf(ur[k][1].w, xb[7], d);
        d = wave_sum(d);
        const float gt = __int_as_float(__builtin_amdgcn_readlane(__float_as_int(pp < 64 ? gt0 : gt1), pp & 63));
        const float w = gt * 0.5f * d * (1.0f + erff(d * 0.70710678118f));
        acc[0] += w * bflo(vr[k][0].x); acc[1] += w * bfhi(vr[k][0].x); acc[2] += w * bflo(vr[k][0].y); acc[3] += w * bfhi(vr[k][0].y);
        acc[4] += w * bflo(vr[k][0].z); acc[5] += w * bfhi(vr[k][0].z); acc[6] += w * bflo(vr[k][0].w); acc[7] += w * bfhi(vr[k][0].w);
        acc[8] += w * bflo(vr[k][1].x); acc[9] += w * bfhi(vr[k][1].x); acc[10] += w * bflo(vr[k][1].y); acc[11] += w * bfhi(vr[k][1].y);
        acc[12] += w * bflo(vr[k][1].z); acc[13] += w * bfhi(vr[k][1].z); acc[14] += w * bflo(vr[k][1].w); acc[15] += w * bfhi(vr[k][1].w); }
    }
    float s = 0.f;
#pragma unroll
    for (int i = 0; i < 16; ++i) { acc[i] += ALPHA * x[i]; s += acc[i]; }
    const float mu = wave_sum(s) * (1.0f / 1024.0f); float q = 0.f;
#pragma unroll
    for (int i = 0; i < 16; ++i) { acc[i] -= mu; q += acc[i] * acc[i]; }
    const float rs = rsqrtf(wave_sum(q) * (1.0f / 1024.0f) + 1e-5f);
#pragma unroll
    for (int hf = 0; hf < 2; ++hf) { const int c = hf * 512 + lane * 8;
      const f32x4 g0 = *(const f32x4*)(g + c), g1 = *(const f32x4*)(g + c + 4), b0 = *(const f32x4*)(bb + c), b1 = *(const f32x4*)(bb + c + 4);
      const f32x4 o0 = (f32x4){acc[8 * hf] * rs, acc[8 * hf + 1] * rs, acc[8 * hf + 2] * rs, acc[8 * hf + 3] * rs} * g0 + b0;
      const f32x4 o1 = (f32x4){acc[8 * hf + 4] * rs, acc[8 * hf + 5] * rs, acc[8 * hf + 6] * rs, acc[8 * hf + 7] * rs} * g1 + b1;
      *(f32x4*)(hout + (size_t)t * 1024 + c) = o0; *(f32x4*)(hout + (size_t)t * 1024 + c + 4) = o1;
      *(u32x4*)(hb + (size_t)t * 1024 + c) = (u32x4){cvt_pk_bf16(o0.x, o0.y), cvt_pk_bf16(o0.z, o0.w), cvt_pk_bf16(o1.x, o1.y), cvt_pk_bf16(o1.z, o1.w)}; }
  }
}
struct EpiAttn {
  static constexpr bool PERM = true, AFTER_DRAIN = false;
  unsigned char* ws; const float* cs;
  __device__ __forceinline__ void operator()(const f32x4 (&acc)[2][2][4][2], const Unit& u, int wr, int wc, int fr, int fq) const {
    const int row0 = u.pm * 256 + wr * 64 + fr;
    if (u.pn < 5) {
      const bool isq = u.pn < 4; const float scale = isq ? 0.125f : 1.0f; const int ld = isq ? 1024 : 256;
      bf16_t* dst = (bf16_t*)(ws + (isq ? R_Q : R_KB)) + (isq ? u.pn * 256 : 0) + wc * 32 + 8 * fq;
      const bool ropewave = (wc & 1) == 0;
#pragma unroll
      for (int ai = 0; ai < 2; ++ai)
#pragma unroll
        for (int m = 0; m < 4; ++m) { const int row = row0 + ai * 128 + m * 16;
          f32x4 c4[4];
          if (ropewave) {
#pragma unroll
            for (int i = 0; i < 4; ++i) c4[i] = *(const f32x4*)(cs + (size_t)row * 16 + i * 4); }
#pragma unroll
          for (int bj = 0; bj < 2; ++bj) { f32x4 v0 = acc[ai][bj][m][0], v1 = acc[ai][bj][m][1];
            if (ropewave) {
              f32x4 p0, p1;
#pragma unroll
              for (int j = 0; j < 4; ++j) { p0[j] = __shfl_xor(v0[j], 16); p1[j] = __shfl_xor(v1[j], 16); }
              const float sg = (fq == 0) ? -1.0f : 1.0f;
              if (fq < 2) {
                v0[0] = v0[0] * c4[0].x + sg * p0[0] * c4[0].y; v0[1] = v0[1] * c4[0].z + sg * p0[1] * c4[0].w; v0[2] = v0[2] * c4[1].x + sg * p0[2] * c4[1].y; v0[3] = v0[3] * c4[1].z + sg * p0[3] * c4[1].w;
                v1[0] = v1[0] * c4[2].x + sg * p1[0] * c4[2].y; v1[1] = v1[1] * c4[2].z + sg * p1[1] * c4[2].w; v1[2] = v1[2] * c4[3].x + sg * p1[2] * c4[3].y; v1[3] = v1[3] * c4[3].z + sg * p1[3] * c4[3].w;
              }
            }
            v0 = v0 * scale; v1 = v1 * scale;
            u32x4 w; w.x = cvt_pk_bf16(v0[0], v0[1]); w.y = cvt_pk_bf16(v0[2], v0[3]); w.z = cvt_pk_bf16(v1[0], v1[1]); w.w = cvt_pk_bf16(v1[2], v1[3]);
            *(u32x4*)(dst + (size_t)row * ld + bj * 128) = w; } }
    } else {
      bf16_t* vT = (bf16_t*)(ws + R_VT);
#pragma unroll
      for (int ai = 0; ai < 2; ++ai)
#pragma unroll
        for (int m = 0; m < 4; ++m) { const int row = row0 + ai * 128 + m * 16, b = row >> 12, s = row & 4095;
#pragma unroll
          for (int bj = 0; bj < 2; ++bj)
#pragma unroll
            for (int n = 0; n < 2; ++n) { const int col = bj * 128 + wc * 32 + 8 * fq + 4 * n;
              bf16_t* d0 = vT + ((size_t)(b * 4 + (col >> 6)) * 64 + (col & 63)) * 4096 + s;
              const unsigned w0 = cvt_pk_bf16(acc[ai][bj][m][n][0], acc[ai][bj][m][n][1]), w1 = cvt_pk_bf16(acc[ai][bj][m][n][2], acc[ai][bj][m][n][3]);
              d0[0] = (bf16_t)(w0 & 0xffffu); d0[4096] = (bf16_t)(w0 >> 16); d0[2 * 4096] = (bf16_t)(w1 & 0xffffu); d0[3 * 4096] = (bf16_t)(w1 >> 16); } }
    }
  }
};
__device__ __forceinline__ void phase_gemm_qkv(const P& p, LAS unsigned char* lds, int bid, int nb) {
  EpiAttn E; E.ws = p.ws; E.cs = (const float*)(p.ws + WS_CS);
  run_gemm(lds, (const bf16_t*)(p.ws + WS_HB16), (const bf16_t*)(p.ws + WS_WT_QKV), T, 1536, 1024, E, bid, nb);
}
__device__ __forceinline__ void phase_attn(const P& p, int bid, int nb) {
  const int lane = threadIdx.x & 63, wid = threadIdx.x >> 6, l31 = lane & 31, hh = lane >> 5;
  const bf16_t* q = (const bf16_t*)(p.ws + R_Q); const bf16_t* kb = (const bf16_t*)(p.ws + R_KB); const bf16_t* vT = (const bf16_t*)(p.ws + R_VT); bf16_t* ao = (bf16_t*)(p.ws + R_AO);
  for (int wt = bid * 8 + wid; wt < 8192; wt += nb * 8) {
    const int qb = wt & 127, hq = (wt >> 7) & 15, b = wt >> 11, kvh = hq >> 2, i0 = qb * 32, k0 = i0 - 128;
    const float sink = p.sw_sinks[hq];
    bf16x8 bq[4];
#pragma unroll
    for (int ks = 0; ks < 4; ++ks) bq[ks] = *(const bf16x8*)(q + (size_t)(b * SEQ + i0 + l31) * 1024 + hq * 64 + ks * 16 + hh * 8);
    f32x16 s[5];
#pragma unroll
    for (int kt = 0; kt < 5; ++kt) {
      for (int i = 0; i < 16; ++i) s[kt][i] = 0.f;
      const int kb0 = k0 + kt * 32;
      if (kb0 >= 0) {
        const bf16_t* kp = kb + (size_t)(b * SEQ + kb0 + l31) * 256 + kvh * 64 + hh * 8;
#pragma unroll
        for (int ks = 0; ks < 4; ++ks) { const bf16x8 a = *(const bf16x8*)(kp + ks * 16); s[kt] = MFMA32(a, bq[ks], s[kt]); }
      }
    }
    const int qp = i0 + l31; float m = sink;
#pragma unroll
    for (int kt = 0; kt < 5; ++kt)
#pragma unroll
      for (int r = 0; r < 16; ++r) { const int kp = k0 + kt * 32 + (r & 3) + 8 * (r >> 2) + 4 * hh; const bool valid = (kp >= 0) && (kp <= qp) && (kp > qp - 128);
        s[kt][r] = valid ? s[kt][r] : -INFINITY; m = fmaxf(m, s[kt][r]); }
    m = fmaxf(m, __shfl_xor(m, 32));
    float lsum = 0.f;
#pragma unroll
    for (int kt = 0; kt < 5; ++kt)
#pragma unroll
      for (int r = 0; r < 16; ++r) { const float e = fast_exp(s[kt][r] - m); s[kt][r] = e; lsum += e; }
    lsum += __shfl_xor(lsum, 32); lsum += fast_exp(sink - m);
    f32x16 o[2];
    for (int i = 0; i < 16; ++i) { o[0][i] = 0.f; o[1][i] = 0.f; }
#pragma unroll
    for (int kt = 0; kt < 5; ++kt) {
      const int kb0 = k0 + kt * 32;
      if (kb0 >= 0) {
#pragma unroll
        for (int st = 0; st < 2; ++st) {
          u32x4 pk; pk.x = cvt_pk_bf16(s[kt][8 * st], s[kt][8 * st + 1]); pk.y = cvt_pk_bf16(s[kt][8 * st + 2], s[kt][8 * st + 3]);
          pk.z = cvt_pk_bf16(s[kt][8 * st + 4], s[kt][8 * st + 5]); pk.w = cvt_pk_bf16(s[kt][8 * st + 6], s[kt][8 * st + 7]);
          const bf16x8 pb = __builtin_bit_cast(bf16x8, pk);
#pragma unroll
          for (int et = 0; et < 2; ++et) { const bf16_t* vp = vT + ((size_t)(b * 4 + kvh) * 64 + et * 32 + l31) * 4096 + kb0 + 16 * st + 4 * hh;
            const u32x2 lo = *(const u32x2*)vp, hi = *(const u32x2*)(vp + 8);
            const bf16x8 a = __builtin_bit_cast(bf16x8, (u32x4){lo.x, lo.y, hi.x, hi.y});
            o[et] = MFMA32(a, pb, o[et]); }
        }
      }
    }
    const float inv = 1.0f / lsum;
#pragma unroll
    for (int et = 0; et < 2; ++et)
#pragma unroll
      for (int g = 0; g < 4; ++g)
        *(u32x2*)(ao + (size_t)(b * SEQ + i0 + l31) * 1024 + hq * 64 + et * 32 + 8 * g + 4 * hh) =
            (u32x2){cvt_pk_bf16(o[et][4 * g] * inv, o[et][4 * g + 1] * inv), cvt_pk_bf16(o[et][4 * g + 2] * inv, o[et][4 * g + 3] * inv)};
  }
}
__device__ __forceinline__ void phase_gemm_swo(const P& p, LAS unsigned char* lds, int bid, int nb) {
  EpiResid E; E.res = p.out; E.z = (float*)(p.ws + R_Z);
  run_gemm(lds, (const bf16_t*)(p.ws + R_AO), (const bf16_t*)(p.ws + WS_WT_SWO), T, 1024, 1024, E, bid, nb);
}
__global__ __launch_bounds__(512, 2) void mega_fwd(P p) {
  extern __shared__ __attribute__((aligned(16))) unsigned char shm[];
  LAS unsigned char* lds = (LAS unsigned char*)shm;
  cooperative_groups::grid_group grid = cooperative_groups::this_grid();
  const int bid = blockIdx.x, nb = gridDim.x;
  volatile LAS unsigned* xst = (volatile LAS unsigned*)(lds + 131072);
  if (threadIdx.x < 4) xst[threadIdx.x] = 0u;
  __syncthreads();
  const XcdBarrier xb = xcd_barrier_post((unsigned*)(p.ws + WS_CTL), xst);
  float* hA = (float*)(p.ws + WS_HA); bf16_t* hb = (bf16_t*)(p.ws + WS_HB16); const float* z = (const float*)(p.ws + R_Z);
  phase_prep(p, lds, bid, nb);            grid.sync();
  phase_gemm1(p, lds, bid, nb);           xcd_barrier(xb);
  phase_hgrn_a(p, lds, bid, nb);          xcd_barrier(xb);
  phase_hgrn_b(p, bid, nb);               xcd_barrier(xb);
  phase_hgrn_c(p, bid, nb);               xcd_barrier(xb);
  phase_gemm2(p, lds, bid, nb);           xcd_barrier(xb);
  phase_ln(z, p.ln_mix_g, p.ln_mix_b, hA, hb, bid, nb);   xcd_barrier(xb);
  phase_peer_scores(p, 0, lds, bid, nb);  xcd_barrier(xb);
  phase_peer_topk(p, bid, nb);            xcd_barrier(xb);
  phase_peer_gather<8>(p, 0, hA, p.out, bid, nb);         xcd_barrier(xb);
  phase_gemm_qkv(p, lds, bid, nb);        xcd_barrier(xb);
  phase_attn(p, bid, nb);                 xcd_barrier(xb);
  phase_gemm_swo(p, lds, bid, nb);        xcd_barrier(xb);
  phase_ln(z, p.ln_mix_g + 1024, p.ln_mix_b + 1024, hA, hb, bid, nb);   xcd_barrier(xb);
  phase_peer_scores(p, 1, lds, bid, nb);  xcd_barrier(xb);
  phase_peer_topk(p, bid, nb);            xcd_barrier(xb);
  phase_peer_gather<8>(p, 1, hA, p.out, bid, nb);
}
}

extern "C" void kernel_launch(void* const* d_in, const int* in_sizes, int n_in, void* d_out, int out_size, void* d_ws, size_t ws_size, hipStream_t stream) {
  constexpr int LDSB = 131072 + 16;
  static int grid_blocks = 0;
  if (!grid_blocks) {
    int dev = 0, cus = 0, per_cu = 0;
    hipGetDevice(&dev);
    hipDeviceGetAttribute(&cus, hipDeviceAttributeMultiprocessorCount, dev);
    hipFuncSetAttribute((const void*)mk::mega_fwd, hipFuncAttributeMaxDynamicSharedMemorySize, LDSB);
    hipOccupancyMaxActiveBlocksPerMultiprocessor(&per_cu, (const void*)mk::mega_fwd, 512, LDSB);
    if (per_cu < 1) per_cu = 1;
    if (per_cu > 1) per_cu = 1;
    grid_blocks = cus * per_cu;
  }
  mk::P p{};
  p.x = (const float*)d_in[0]; p.pos = (const int*)d_in[1]; p.hg_w_in = (const float*)d_in[2]; p.hg_lb = (const float*)d_in[3]; p.hg_norm_w = (const float*)d_in[4];
  p.hg_w_o = (const float*)d_in[5]; p.sw_w_q = (const float*)d_in[6]; p.sw_sinks = (const float*)d_in[7]; p.sw_w_o = (const float*)d_in[8]; p.w_kv = (const float*)d_in[9];
  p.peer_w_q = (const float*)d_in[10]; p.peer_sk = (const float*)d_in[11]; p.peer_u = (const float*)d_in[12]; p.peer_v = (const float*)d_in[13];
  p.ln_mix_g = (const float*)d_in[14]; p.ln_mix_b = (const float*)d_in[15]; p.ln_ffn_g = (const float*)d_in[16]; p.ln_ffn_b = (const float*)d_in[17];
  p.out = (float*)d_out; p.ws = (unsigned char*)d_ws;
  hipMemsetAsync(d_ws, 0, XCD_BAR_WORDS * 4, stream);
  void* args[] = {&p};
  hipError_t e = hipLaunchCooperativeKernel((const void*)mk::mega_fwd, dim3(grid_blocks), dim3(512), args, LDSB, stream);
  if (e != hipSuccess) fprintf(stderr, "cooperative launch failed: %s (grid %d)\n", hipGetErrorString(e), grid_blocks);
}
```

```cpp
#include <hip/hip_runtime.h>
#include <hip/hip_cooperative_groups.h>
#include <math.h>
#include <cstdio>
namespace pg8 {
__device__ __forceinline__ int opaque_tid() { int t = (int)threadIdx.x; asm volatile("" : "+v"(t)); return t; }
#define PG8_LAS __attribute__((address_space(3)))
typedef unsigned short bf16_t;
typedef short bf16x8 __attribute__((ext_vector_type(8)));
typedef float f32x4 __attribute__((ext_vector_type(4)));
typedef unsigned u32x4 __attribute__((ext_vector_type(4)));
constexpr int BM = 256, BK = 64, HALF = 128, HTB = HALF * BK * 2  , STAGE_BYTES = 8 * HTB, NXCD = 8, WGM = 8;

__host__ __device__ __forceinline__ int lds_byte(int r, int c) { const int st = (r >> 4) * 2 + (c >> 5), rr = r & 15, cc = c & 31, ob = rr * 64 + cc * 2; return st * 1024 + (ob ^ (((ob >> 9) & 1) << 5)); }
__host__ __device__ __forceinline__ void stage_rc(int b, int& R, int& C) { const int st = b / 1024, sb = b % 1024, swz = sb ^ (((sb >> 9) & 1) << 5); R = (st >> 1) * 16 + swz / 64; C = (st & 1) * 32 + (swz % 64) / 2; }
__host__ __device__ __forceinline__ int perm32(int rho) { const int n = rho >> 4, i = rho & 15; return 8 * (i >> 2) + 4 * n + (i & 3); }

struct Unit { int pm, pn; };
struct Gemm { const bf16_t* A; const bf16_t* Bt; int M, N, K; };

struct StaticOrder {
    int nM, nN, nwg, G, c;
    __host__ __device__ void init(int M, int N, int G_, int c_) { nM = M / BM; nN = N / BM; nwg = nM * nN; G = G_; c = c_; }
    __host__ __device__ bool next(int i, Unit& u) const {
        const long L = (long)i * G + c; if (L >= nwg) return false;
        int wgid = (int)L; { const int q = nwg / NXCD, r = nwg % NXCD, xcd = wgid % NXCD, off = wgid / NXCD; wgid = (xcd < r ? xcd * (q + 1) : r * (q + 1) + (xcd - r) * q) + off; }
        const int nig = WGM * nN, gid = wgid / nig, fm = gid * WGM, gsz = (nM - fm) < WGM ? (nM - fm) : WGM;
        u.pm = fm + ((wgid % nig) % gsz); u.pn = (wgid % nig) / gsz; return true;
    }
    __device__ __forceinline__ void a_ready(const Unit&) const {}
    __device__ __forceinline__ void done(const Unit&) const {}
};
typedef __bf16 bf16v2_t __attribute__((ext_vector_type(2)));
typedef float f32v2_t __attribute__((ext_vector_type(2)));
__device__ __forceinline__ unsigned cvt_pk_bf16(float lo, float hi) { const f32v2_t v = {lo, hi}; return __builtin_bit_cast(unsigned, __builtin_convertvector(v, bf16v2_t)); }
typedef float f32x2 __attribute__((ext_vector_type(2)));

template <class Epi, class Sched, bool STAMP = false>
__device__ __forceinline__ void gemm_phase(PG8_LAS unsigned char* lds, const Gemm g, const Sched& S, const Epi& E, unsigned long long* stamps) {
    const int tid = opaque_tid(), wid = __builtin_amdgcn_readfirstlane(tid >> 6), lane = tid & 63, wr = wid >> 2, wc = wid & 3, fr = lane & 15, fq = lane >> 4;
    const int K = g.K, nt = K / BK;
    int ts_lo = 0, ts_hi = 0, nts = 0; const unsigned long long rt_entry = STAMP ? (unsigned long long)wall_clock64() : 0ull;
#define PG8_STAMP() do { if (STAMP && wid == 0 && nts < 64) { const unsigned long long _c = (unsigned long long)clock64(); \
        ts_lo = (lane == nts) ? (int)(unsigned)_c : ts_lo; ts_hi = (lane == nts) ? (int)(unsigned)(_c >> 32) : ts_hi; ++nts; } } while (0)
    PG8_STAMP();
    unsigned voffA[2], voffB[2];
#pragma unroll
    for (int i = 0; i < 2; ++i) { int R, C; stage_rc(tid * 16 + i * 8192, R, C); const int Rb = Epi::PERM ? ((R & ~31) + perm32(R & 31)) : R;
        voffA[i] = (unsigned)(R * K + C) * 2u; voffB[i] = (unsigned)(Rb * K + C) * 2u; }
    const size_t kstep = (size_t)(BK * 2);
    const size_t hstep = (size_t)HALF * K * 2;
    const size_t tstep = 2 * hstep;
    const unsigned ldsw = (unsigned)wid * 1024u;
    const int aoff = lds_byte(wr * 64 + fr, fq * 8), boff = lds_byte(wc * 32 + fr, fq * 8);
#define PG8_SA(b, h) (((b) * 2 + (h)) * HTB)
#define PG8_SB(b, h) ((4 + (b) * 2 + (h)) * HTB)
#define PG8_STAGE(bufoff, gbase, voff) do { _Pragma("unroll") for (int _i = 0; _i < 2; ++_i) \
        __builtin_amdgcn_global_load_lds((const unsigned*)((const char*)(gbase) + (voff)[_i]), (PG8_LAS unsigned*)(lds + (bufoff) + ldsw + _i * 8192), 16, 0, 0); } while (0)
#define PG8_LDA(dst, b, h) do { _Pragma("unroll") for (int m = 0; m < 4; ++m) _Pragma("unroll") for (int k = 0; k < 2; ++k) dst[m][k] = *(const PG8_LAS bf16x8*)(lds + PG8_SA(b, h) + aoff + m * 2048 + k * 1024); } while (0)
#define PG8_LDB(dst, b, h) do { _Pragma("unroll") for (int n = 0; n < 2; ++n) _Pragma("unroll") for (int k = 0; k < 2; ++k) dst[n][k] = *(const PG8_LAS bf16x8*)(lds + PG8_SB(b, h) + boff + n * 2048 + k * 1024); } while (0)
#define PG8_MMA(ai, bj, At, Bt) do { __builtin_amdgcn_s_setprio(1); _Pragma("unroll") for (int m = 0; m < 4; ++m) _Pragma("unroll") for (int n = 0; n < 2; ++n) _Pragma("unroll") for (int k = 0; k < 2; ++k) \
        acc[ai][bj][m][n] = __builtin_amdgcn_mfma_f32_16x16x32_bf16(Bt[n][k], At[m][k], acc[ai][bj][m][n], 0, 0, 0); __builtin_amdgcn_s_setprio(0); } while (0)
#define PG8_WAIT_V(n) asm volatile("s_waitcnt vmcnt(" #n ")" ::: "memory")
#define PG8_WAIT_L(n) asm volatile("s_waitcnt lgkmcnt(" #n ")" ::: "memory")
#define PG8_BAR __builtin_amdgcn_s_barrier()
#define PG8_SCHED __builtin_amdgcn_sched_barrier(0)
    Unit cur, nxt; int ui = 0;
    if (!S.next(0, cur)) return;
    f32x4 acc[2][2][4][2];
#pragma unroll
    for (int a = 0; a < 2; ++a)
#pragma unroll
        for (int b = 0; b < 2; ++b)
#pragma unroll
            for (int m = 0; m < 4; ++m)
#pragma unroll
                for (int n = 0; n < 2; ++n) acc[a][b][m][n] = (f32x4){0.f, 0.f, 0.f, 0.f};
    bf16x8 At[4][2], B0[2][2], B1[2][2];
    const char* cA = (const char*)g.A + (size_t)cur.pm * tstep; const char* cB = (const char*)g.Bt + (size_t)cur.pn * tstep;
    S.a_ready(cur);
    PG8_STAGE(PG8_SB(0, 0), cB, voffB); PG8_STAGE(PG8_SA(0, 0), cA, voffA); PG8_STAGE(PG8_SB(0, 1), cB + hstep, voffB); PG8_STAGE(PG8_SA(0, 1), cA + hstep, voffA);
    if (wr == 1) PG8_BAR;
    PG8_WAIT_V(4); PG8_BAR;
    PG8_STAGE(PG8_SB(1, 0), cB + kstep, voffB); PG8_STAGE(PG8_SA(1, 0), cA + kstep, voffA); PG8_STAGE(PG8_SB(1, 1), cB + hstep + kstep, voffB);
    PG8_WAIT_V(6); PG8_BAR;
    PG8_STAMP();
    for (;;) {
        const bool has_next = S.next(ui + 1, nxt);
        const char* nA = has_next ? (const char*)g.A + (size_t)nxt.pm * tstep : cA; const char* nB = has_next ? (const char*)g.Bt + (size_t)nxt.pn * tstep : cB;
        for (int t = 0; t < nt; t += 2) {
            const bool last = (t == nt - 2);
            const char* a1 = cA + (size_t)(t + 1) * kstep;
            const char* a2 = last ? nA : cA + (size_t)(t + 2) * kstep; const char* b2 = last ? nB : cB + (size_t)(t + 2) * kstep;
            const char* a3 = a2 + kstep; const char* b3 = b2 + kstep;
            if (last && has_next) S.a_ready(nxt);
            PG8_LDB(B0, 0, 0); PG8_SCHED; PG8_LDA(At, 0, 0); PG8_STAGE(PG8_SA(1, 1), a1 + hstep, voffA);
            PG8_WAIT_L(8); PG8_BAR; PG8_WAIT_L(0); PG8_MMA(0, 0, At, B0); PG8_BAR; PG8_SCHED;
            PG8_LDB(B1, 0, 1); PG8_STAGE(PG8_SB(0, 0), b2, voffB);
            PG8_BAR; PG8_WAIT_L(0); PG8_MMA(0, 1, At, B1); PG8_BAR;
            PG8_LDA(At, 0, 1); PG8_STAGE(PG8_SA(0, 0), a2, voffA);
            PG8_BAR; PG8_WAIT_L(0); PG8_MMA(1, 0, At, B0); PG8_BAR; PG8_SCHED;
            PG8_STAGE(PG8_SB(0, 1), b2 + hstep, voffB);
            PG8_WAIT_V(6); PG8_BAR; PG8_MMA(1, 1, At, B1); PG8_BAR;
            PG8_LDB(B0, 1, 0); PG8_SCHED; PG8_LDA(At, 1, 0); PG8_STAGE(PG8_SA(0, 1), a2 + hstep, voffA);
            PG8_WAIT_L(8); PG8_BAR; PG8_WAIT_L(0); PG8_MMA(0, 0, At, B0); PG8_BAR; PG8_SCHED;
            PG8_LDB(B1, 1, 1); PG8_STAGE(PG8_SB(1, 0), b3, voffB);
            PG8_BAR; PG8_WAIT_L(0); PG8_MMA(0, 1, At, B1); PG8_BAR;
            PG8_LDA(At, 1, 1); PG8_STAGE(PG8_SA(1, 0), a3, voffA);
            PG8_BAR; PG8_WAIT_L(0); PG8_MMA(1, 0, At, B0); PG8_BAR; PG8_SCHED;
            PG8_STAGE(PG8_SB(1, 1), b3 + hstep, voffB);
            PG8_WAIT_V(6); PG8_BAR; PG8_MMA(1, 1, At, B1); PG8_BAR;
        }
        PG8_STAMP();
        if constexpr (!Epi::AFTER_DRAIN) { E(acc, cur, wr, wc, fr, fq); S.done(cur); }
        PG8_STAMP();
        if (!has_next) break;
#pragma unroll
        for (int a = 0; a < 2; ++a)
#pragma unroll
            for (int b = 0; b < 2; ++b)
#pragma unroll
                for (int m = 0; m < 4; ++m)
#pragma unroll
                    for (int n = 0; n < 2; ++n) acc[a][b][m][n] = (f32x4){0.f, 0.f, 0.f, 0.f};
        cur = nxt; cA = nA; cB = nB; ++ui;
    }
    PG8_WAIT_V(0);
    if (wr == 0) PG8_BAR;
    PG8_BAR;
    if constexpr (Epi::AFTER_DRAIN) { E.fused(acc, cur, wr, wc, fr, fq, lds, wid, lane); S.done(cur); }
    PG8_STAMP();
    if (STAMP && wid == 0) { stamps[lane] = lane < nts ? (((unsigned long long)(unsigned)ts_hi << 32) | (unsigned)ts_lo) : 0ull;
        if (lane == 62) stamps[62] = rt_entry; if (lane == 63) stamps[63] = (unsigned long long)wall_clock64(); }
#undef PG8_STAMP
#undef PG8_SA
#undef PG8_SB
#undef PG8_STAGE
#undef PG8_LDA
#undef PG8_LDB
#undef PG8_MMA
#undef PG8_WAIT_V
#undef PG8_WAIT_L
#undef PG8_BAR
#undef PG8_SCHED
}
}
namespace mk {
using pg8::bf16_t; using pg8::f32x4; using pg8::u32x4; using pg8::bf16x8; using pg8::Unit; using pg8::cvt_pk_bf16;
#define LAS __attribute__((address_space(3)))
typedef unsigned u32x2 __attribute__((ext_vector_type(2)));
typedef float f32x16 __attribute__((ext_vector_type(16)));
constexpr int T = 16384, D = 1024, SEQ = 4096, NTHR = 512;
constexpr float ALPHA = 1.41421356237f;
constexpr size_t MB = (size_t)1 << 20;
constexpr size_t WS_CTL = 0, WS_LBV = 1 * MB, WS_CS = 2 * MB, WS_WT_IN = 4 * MB, WS_WT_O = 12 * MB, WS_WT_QKV = 14 * MB, WS_WT_SWO = 17 * MB, WS_WT_PEER = 19 * MB,
                 WS_SCL = 3 * MB, WS_TABU = 32 * MB, WS_TABV = 64 * MB, WS_HA = 160 * MB, WS_HB16 = 224 * MB, WS_R3 = 256 * MB;
constexpr size_t R_QS = WS_R3, R_LF = WS_R3 + 32 * MB, R_VI = WS_R3 + 96 * MB, R_GS = WS_R3 + 128 * MB, R_ST = WS_R3 + 160 * MB, R_DEC = WS_R3 + 224 * MB, R_Z = WS_R3 + 160 * MB;
constexpr size_t R_SC = WS_R3, R_EIDX = WS_R3 + 128 * MB, R_GATE = WS_R3 + 136 * MB;
constexpr size_t R_Q = WS_R3, R_KB = WS_R3 + 32 * MB, R_VT = WS_R3 + 40 * MB, R_AO = WS_R3 + 48 * MB;

struct P {
  const float* x; const int* pos; const float *hg_w_in, *hg_lb, *hg_norm_w, *hg_w_o, *sw_w_q, *sw_sinks, *sw_w_o, *w_kv, *peer_w_q, *peer_sk, *peer_u, *peer_v,
      *ln_mix_g, *ln_mix_b, *ln_ffn_g, *ln_ffn_b;
  float* out; unsigned char* ws;
};

__device__ __forceinline__ float bf2f(unsigned short b) { return __uint_as_float(((unsigned)b) << 16); }
__device__ __forceinline__ float bflo(unsigned w) { return __uint_as_float(w << 16); }
__device__ __forceinline__ float bfhi(unsigned w) { return __uint_as_float(w & 0xffff0000u); }
__device__ __forceinline__ float fast_exp(float x) { return __builtin_amdgcn_exp2f(x * 1.44269504089f); }
__device__ __forceinline__ float fast_rcp(float x) { return __builtin_amdgcn_rcpf(x); }
__device__ __forceinline__ float fast_sigmoid(float x) { return fast_rcp(1.0f + fast_exp(-x)); }
__device__ __forceinline__ float fast_silu(float x) { return x * fast_sigmoid(x); }
__device__ __forceinline__ float wave_sum(float v) {
#pragma unroll
  for (int o = 1; o < 64; o <<= 1) v += __shfl_xor(v, o);
  return v;
}
typedef float f32x2 __attribute__((ext_vector_type(2)));
__device__ __forceinline__ unsigned pk4_fp8(float a, float b, float c, float d) { int w = 0; w = __builtin_amdgcn_cvt_pk_fp8_f32(a, b, w, false); w = __builtin_amdgcn_cvt_pk_fp8_f32(c, d, w, true); return (unsigned)w; }
#define XB_TMO      128
#define XB_XCNT(j)  (256  + 64 * (j))
#define XB_XSUB(j)  (1280 + 64 * (j))
#define XB_XGEN(j)  (2304 + 64 * (j))
#define XB_TOP      3328
#define XB_TOPGEN   3392
#define XCD_BAR_WORDS 3456
#define XB_SPIN_CAP (1u << 18)


__device__ __forceinline__ unsigned xb_ld(unsigned* p)              { return __hip_atomic_load(p, __ATOMIC_RELAXED, __HIP_MEMORY_SCOPE_AGENT); }
__device__ __forceinline__ unsigned xb_add(unsigned* p, unsigned v) { return __hip_atomic_fetch_add(p, v, __ATOMIC_RELAXED, __HIP_MEMORY_SCOPE_AGENT); }
__device__ __forceinline__ unsigned xb_xcc_id() { return (unsigned)__builtin_amdgcn_s_getreg((3 << 11) | 20) & 0xFu; }
#define XB_SPIN(cond, bar) do { unsigned _sp = 0; while (cond) { __builtin_amdgcn_s_sleep(1); \
    if ((++_sp & 255u) == 0u) { if (xb_ld(&(bar)[XB_TMO])) break; if (_sp > XB_SPIN_CAP) { atomicAdd(&(bar)[XB_TMO], 1u); break; } } } } while (0)

struct XcdBarrier {
    unsigned* bar; unsigned x;
    volatile LAS unsigned* st;
};

__device__ __forceinline__ XcdBarrier xcd_barrier_post(unsigned* bar, volatile LAS unsigned* st) {
    XcdBarrier b; b.bar = bar; b.x = xb_xcc_id(); b.st = st;
    if (threadIdx.x == 0) (void)xb_add(&bar[XB_XCNT(b.x)], 1u);
    return b;
}
__device__ __forceinline__ void xcd_barrier_complete(unsigned* bar, unsigned x, unsigned& nloc, unsigned& nx) {
    const unsigned G = gridDim.x * gridDim.y * gridDim.z;
    unsigned sum, cnt, mine, sp = 0u;
    for (;;) {
        sum = 0u; cnt = 0u; mine = 0u;
#pragma unroll
        for (unsigned j = 0; j < 16; ++j) { const unsigned c = xb_ld(&bar[XB_XCNT(j)]); sum += c; cnt += (c > 0u) ? 1u : 0u; mine = (j == x) ? c : mine; }
        if (sum == G) break;
        __builtin_amdgcn_s_sleep(1);
        if ((++sp & 255u) == 0u) { if (xb_ld(&bar[XB_TMO])) break; if (sp > XB_SPIN_CAP) { atomicAdd(&bar[XB_TMO], 1u); break; } }
    }
    nloc = mine > 0u ? mine : 1u; nx = cnt > 0u ? cnt : 1u;
}

__device__ __forceinline__ void xcd_barrier(const XcdBarrier& b) {
    asm volatile("s_waitcnt vmcnt(0)" ::: "memory");
    __syncthreads();
    if (threadIdx.x == 0) {
        unsigned* bar = b.bar;
        __builtin_amdgcn_s_waitcnt(0);
        unsigned nloc = b.st[0], nx = b.st[1];
        if (nloc == 0u) { xcd_barrier_complete(bar, b.x, nloc, nx); b.st[0] = nloc; b.st[1] = nx; }
        const unsigned old = xb_add(&bar[XB_XSUB(b.x)], 1u);
        const unsigned gen = old / nloc;
        if (old + 1u == (gen + 1u) * nloc) {
            __builtin_amdgcn_fence(__ATOMIC_RELEASE, "agent");
            asm volatile("s_waitcnt vmcnt(0)" ::: "memory");
            const unsigned og = xb_add(&bar[XB_TOP], 1u);
            const unsigned tg = og / nx;
            if (og + 1u == (tg + 1u) * nx) xb_add(&bar[XB_TOPGEN], 1u);
            else XB_SPIN(xb_ld(&bar[XB_TOPGEN]) == tg, bar);
            __builtin_amdgcn_fence(__ATOMIC_ACQUIRE, "agent");
            xb_add(&bar[XB_XGEN(b.x)], 1u);
            asm volatile("s_waitcnt vmcnt(0)" ::: "memory");
        } else {
            XB_SPIN(xb_ld(&bar[XB_XGEN(b.x)]) == gen, bar);
            __builtin_amdgcn_fence(__ATOMIC_ACQUIRE, "agent");
            asm volatile("s_waitcnt vmcnt(0)" ::: "memory");
        }
    }
    __syncthreads();
}
__device__ __forceinline__ void cvt_stream(const float* __restrict__ src, bf16_t* __restrict__ dst, size_t n, size_t gtid, size_t gthreads) {
  const size_t n8 = n >> 3;
  for (size_t i = gtid; i < n8; i += gthreads) {
    const f32x4 a = ((const f32x4*)src)[2 * i], b = ((const f32x4*)src)[2 * i + 1];
    u32x4 o; o.x = cvt_pk_bf16(a.x, a.y); o.y = cvt_pk_bf16(a.z, a.w); o.z = cvt_pk_bf16(b.x, b.y); o.w = cvt_pk_bf16(b.z, b.w);
    ((u32x4*)dst)[i] = o;
  }
}
__device__ __forceinline__ void cvt_rows_fp8(const float* __restrict__ src, unsigned char* __restrict__ dst, float* __restrict__ scl, int nrows, int gw, int ngw, int lane) {
  for (int r = gw; r < nrows; r += ngw) {
    const float* s = src + (size_t)r * 1024 + lane * 16;
    f32x4 v[4]; float m = 0.f;
#pragma unroll
    for (int i = 0; i < 4; ++i) { v[i] = *(const f32x4*)(s + 4 * i); m = fmaxf(fmaxf(m, fmaxf(fabsf(v[i].x), fabsf(v[i].y))), fmaxf(fabsf(v[i].z), fabsf(v[i].w))); }
#pragma unroll
    for (int o = 1; o < 64; o <<= 1) m = fmaxf(m, __shfl_xor(m, o));
    const float sc = m > 0.f ? 440.0f / m : 1.0f;
    u32x4 o4;
    o4.x = pk4_fp8(v[0].x * sc, v[0].y * sc, v[0].z * sc, v[0].w * sc); o4.y = pk4_fp8(v[1].x * sc, v[1].y * sc, v[1].z * sc, v[1].w * sc);
    o4.z = pk4_fp8(v[2].x * sc, v[2].y * sc, v[2].z * sc, v[2].w * sc); o4.w = pk4_fp8(v[3].x * sc, v[3].y * sc, v[3].z * sc, v[3].w * sc);
    *(u32x4*)(dst + (size_t)r * 1024 + lane * 16) = o4;
    if (lane == 0) scl[r] = m > 0.f ? m * (1.0f / 440.0f) : 1.0f;
  }
}
__device__ __forceinline__ void transpose_tile(const float* __restrict__ W, int K, int N, bf16_t* __restrict__ Wt, int row_off, int tile, LAS float* scr, int tid) {
  const int ntn = N / 64, kb = tile / ntn, nbk = tile % ntn, k0 = kb * 64, n0 = nbk * 64;
  { const int k = tid >> 3, n8 = (tid & 7) * 8;
    const f32x4 a = *(const f32x4*)(W + (size_t)(k0 + k) * N + n0 + n8), b = *(const f32x4*)(W + (size_t)(k0 + k) * N + n0 + n8 + 4);
    LAS float* s = scr + k * 65 + n8; s[0] = a.x; s[1] = a.y; s[2] = a.z; s[3] = a.w; s[4] = b.x; s[5] = b.y; s[6] = b.z; s[7] = b.w; }
  __syncthreads();
  { const int n = tid >> 3, k8 = (tid & 7) * 8; const LAS float* s = scr + k8 * 65 + n;
    u32x4 o; o.x = cvt_pk_bf16(s[0], s[65]); o.y = cvt_pk_bf16(s[130], s[195]); o.z = cvt_pk_bf16(s[260], s[325]); o.w = cvt_pk_bf16(s[390], s[455]);
    *(u32x4*)(Wt + (size_t)(row_off + n0 + n) * K + k0 + k8) = o; }
  __syncthreads();
}
__device__ __forceinline__ void peer_fold_item(const P& p, int item, LAS float* lds, int tid) {
  const int kt = item & 15, hc = (item >> 4) & 15, l = item >> 8, k0 = kt * 64;
  LAS float* sks = lds;
  LAS float* wqs = lds + 128 * 132;
  const float* SK = p.peer_sk + ((size_t)l * 16 + hc) * 128 * 128;
  const float* WQ = p.peer_w_q + (size_t)l * 1024 * 2048 + hc * 128;
  { const int key = tid & 127, dq = tid >> 7;
#pragma unroll
    for (int j = 0; j < 8; ++j) { const int d4 = (dq + 4 * j) * 4; const f32x4 v = *(const f32x4*)(SK + key * 128 + d4);
      sks[(d4 + 0) * 132 + key] = v.x; sks[(d4 + 1) * 132 + key] = v.y; sks[(d4 + 2) * 132 + key] = v.z; sks[(d4 + 3) * 132 + key] = v.w; } }
  { const int k = tid & 63, dq = tid >> 6;
#pragma unroll
    for (int j = 0; j < 4; ++j) { const int d4 = (dq + 8 * j) * 4; const f32x4 v = *(const f32x4*)(WQ + (size_t)(k0 + k) * 2048 + d4);
      wqs[(d4 + 0) * 68 + k] = v.x; wqs[(d4 + 1) * 68 + k] = v.y; wqs[(d4 + 2) * 68 + k] = v.z; wqs[(d4 + 3) * 68 + k] = v.w; } }
  __syncthreads();
  const int kq = tid & 15, keyq = tid >> 4;
  float acc[4][4];
#pragma unroll
  for (int i = 0; i < 4; ++i)
#pragma unroll
    for (int j = 0; j < 4; ++j) acc[i][j] = 0.f;
#pragma unroll 4
  for (int d = 0; d < 128; ++d) {
    const f32x4 a = *(const LAS f32x4*)(sks + d * 132 + keyq * 4), b = *(const LAS f32x4*)(wqs + d * 68 + kq * 4);
    const float av[4] = {a.x, a.y, a.z, a.w}, bv[4] = {b.x, b.y, b.z, b.w};
#pragma unroll
    for (int i = 0; i < 4; ++i)
#pragma unroll
      for (int j = 0; j < 4; ++j) acc[i][j] += av[i] * bv[j];
  }
  bf16_t* Wt = (bf16_t*)(p.ws + WS_WT_PEER) + ((size_t)l * 2048 + hc * 128) * 1024;
#pragma unroll
  for (int i = 0; i < 4; ++i) { u32x2 o; o.x = cvt_pk_bf16(acc[i][0], acc[i][1]); o.y = cvt_pk_bf16(acc[i][2], acc[i][3]);
    *(u32x2*)(Wt + (size_t)(keyq * 4 + i) * 1024 + k0 + kq * 4) = o; }
  __syncthreads();
}
__device__ __forceinline__ void phase_prep(const P& p, LAS unsigned char* lds, int bid, int nb) {
  const int tid = pg8::opaque_tid(); const size_t gtid = (size_t)bid * NTHR + tid, gth = (size_t)nb * NTHR;
  if (gtid < 1024) { const float a0 = p.hg_lb[gtid], a1 = p.hg_lb[1024 + gtid], mx = fmaxf(a0, a1), e0 = expf(a0 - mx), e1 = expf(a1 - mx); ((float*)(p.ws + WS_LBV))[gtid] = e0 / (e0 + e1); }
  for (size_t i = gtid; i < (size_t)T * 8; i += gth) { const int t = (int)(i >> 3), j = (int)(i & 7);
    const double inv = pow(500000.0, -(double)(2 * j) / 16.0), ang = (double)p.pos[t] * inv;
    ((float2*)(p.ws + WS_CS))[i] = make_float2((float)cos(ang), (float)sin(ang)); }
  LAS float* scr = (LAS float*)lds;
  constexpr int T_IN = 16 * 64, T_O = 16 * 16, T_Q = 16 * 16, T_KV = 16 * 8, T_SWO = 16 * 16, NT_ALL = T_IN + T_O + T_Q + T_KV + T_SWO;
  for (int it = bid; it < NT_ALL; it += nb) {
    int r = it;
    if (r < T_IN) { transpose_tile(p.hg_w_in, 1024, 4096, (bf16_t*)(p.ws + WS_WT_IN), 0, r, scr, tid); continue; } r -= T_IN;
    if (r < T_O) { transpose_tile(p.hg_w_o, 1024, 1024, (bf16_t*)(p.ws + WS_WT_O), 0, r, scr, tid); continue; } r -= T_O;
    if (r < T_Q) { transpose_tile(p.sw_w_q, 1024, 1024, (bf16_t*)(p.ws + WS_WT_QKV), 0, r, scr, tid); continue; } r -= T_Q;
    if (r < T_KV) { transpose_tile(p.w_kv, 1024, 512, (bf16_t*)(p.ws + WS_WT_QKV), 1024, r, scr, tid); continue; } r -= T_KV;
    transpose_tile(p.sw_w_o, 1024, 1024, (bf16_t*)(p.ws + WS_WT_SWO), 0, r, scr, tid);
  }
  for (int it = bid; it < 512; it += nb) peer_fold_item(p, it, scr, tid);
  cvt_stream(p.x, (bf16_t*)(p.ws + WS_HB16), (size_t)T * D, gtid, gth);
  cvt_rows_fp8(p.peer_u, p.ws + WS_TABU, (float*)(p.ws + WS_SCL), 32768, bid * 8 + (tid >> 6), nb * 8, tid & 63);
  cvt_rows_fp8(p.peer_v, p.ws + WS_TABV, (float*)(p.ws + WS_SCL) + 32768, 32768, bid * 8 + (tid >> 6), nb * 8, tid & 63);
}
struct EpiHgrn {
  static constexpr bool PERM = true, AFTER_DRAIN = false;
  unsigned char* ws; float* lf; const float* lbv;
  __device__ __forceinline__ void operator()(const f32x4 (&acc)[2][2][4][2], const Unit& u, int wr, int wc, int fr, int fq) const {
    const int sec = u.pn >> 2, row0 = u.pm * 256 + wr * 64 + fr, col0 = (u.pn & 3) * 256 + wc * 32 + 8 * fq;
    if (sec == 1) {
      float lb[2][8];
#pragma unroll
      for (int bj = 0; bj < 2; ++bj) { const f32x4 a = *(const f32x4*)(lbv + col0 + bj * 128), b = *(const f32x4*)(lbv + col0 + bj * 128 + 4);
        lb[bj][0] = a.x; lb[bj][1] = a.y; lb[bj][2] = a.z; lb[bj][3] = a.w; lb[bj][4] = b.x; lb[bj][5] = b.y; lb[bj][6] = b.z; lb[bj][7] = b.w; }
#pragma unroll
      for (int ai = 0; ai < 2; ++ai)
#pragma unroll
        for (int m = 0; m < 4; ++m) { float* rowp = lf + (size_t)(row0 + ai * 128 + m * 16) * 1024 + col0;
#pragma unroll
          for (int bj = 0; bj < 2; ++bj) { f32x4 o[2];
#pragma unroll
            for (int n = 0; n < 2; ++n)
#pragma unroll
              for (int j = 0; j < 4; ++j) { const float l = lb[bj][4 * n + j]; o[n][j] = __logf(l + (1.0f - l) * fast_sigmoid(acc[ai][bj][m][n][j])); }
            *(f32x4*)(rowp + bj * 128) = o[0]; *(f32x4*)(rowp + bj * 128 + 4) = o[1]; } }
    } else {
      const size_t doff = sec == 0 ? R_QS : (sec == 2 ? R_VI : R_GS);
      bf16_t* dst = (bf16_t*)(ws + doff);
#pragma unroll
      for (int ai = 0; ai < 2; ++ai)
#pragma unroll
        for (int m = 0; m < 4; ++m) { bf16_t* rowp = dst + (size_t)(row0 + ai * 128 + m * 16) * 1024 + col0;
#pragma unroll
          for (int bj = 0; bj < 2; ++bj) { f32x4 v0 = acc[ai][bj][m][0], v1 = acc[ai][bj][m][1];
            if (sec != 2) {
#pragma unroll
              for (int j = 0; j < 4; ++j) { v0[j] = fast_silu(v0[j]); v1[j] = fast_silu(v1[j]); } }
            u32x4 w; w.x = cvt_pk_bf16(v0[0], v0[1]); w.y = cvt_pk_bf16(v0[2], v0[3]); w.z = cvt_pk_bf16(v1[0], v1[1]); w.w = cvt_pk_bf16(v1[2], v1[3]);
            *(u32x4*)(rowp + bj * 128) = w; } }
    }
  }
};
struct EpiResid {
  static constexpr bool PERM = false, AFTER_DRAIN = false;
  const float* res; float* z;
  __device__ __forceinline__ void operator()(const f32x4 (&acc)[2][2][4][2], const Unit& u, int wr, int wc, int fr, int fq) const {
    const int row0 = u.pm * 256 + wr * 64 + fr, col0 = u.pn * 256 + wc * 32 + 4 * fq;
#pragma unroll
    for (int ai = 0; ai < 2; ++ai)
#pragma unroll
      for (int m = 0; m < 4; ++m) { const size_t off = (size_t)(row0 + ai * 128 + m * 16) * 1024 + col0;
#pragma unroll
        for (int bj = 0; bj < 2; ++bj)
#pragma unroll
          for (int n = 0; n < 2; ++n) { const f32x4 r = *(const f32x4*)(res + off + bj * 128 + n * 16); *(f32x4*)(z + off + bj * 128 + n * 16) = acc[ai][bj][m][n] + ALPHA * r; } }
  }
};
struct EpiF32 {
  static constexpr bool PERM = false, AFTER_DRAIN = false;
  float* C; int ldc;
  __device__ __forceinline__ void operator()(const f32x4 (&acc)[2][2][4][2], const Unit& u, int wr, int wc, int fr, int fq) const {
    const int row0 = u.pm * 256 + wr * 64 + fr, col0 = u.pn * 256 + wc * 32 + 4 * fq;
#pragma unroll
    for (int ai = 0; ai < 2; ++ai)
#pragma unroll
      for (int m = 0; m < 4; ++m) { float* rowp = C + (size_t)(row0 + ai * 128 + m * 16) * ldc + col0;
#pragma unroll
        for (int bj = 0; bj < 2; ++bj)
#pragma unroll
          for (int n = 0; n < 2; ++n) *(f32x4*)(rowp + bj * 128 + n * 16) = acc[ai][bj][m][n]; }
  }
};

template <class Epi>
__device__ __forceinline__ void run_gemm(LAS unsigned char* lds, const bf16_t* A, const bf16_t* Bt, int M, int N, int K, const Epi& E, int bid, int nb) {
  pg8::Gemm g; g.A = A; g.Bt = Bt; g.M = M; g.N = N; g.K = K;
  pg8::StaticOrder S; S.init(M, N, nb, bid);
  pg8::gemm_phase<Epi, pg8::StaticOrder, false>(lds, g, S, E, nullptr);
}
__device__ __forceinline__ void phase_gemm1(const P& p, LAS unsigned char* lds, int bid, int nb) {
  EpiHgrn E; E.ws = p.ws; E.lf = (float*)(p.ws + R_LF); E.lbv = (const float*)(p.ws + WS_LBV);
  run_gemm(lds, (const bf16_t*)(p.ws + WS_HB16), (const bf16_t*)(p.ws + WS_WT_IN), T, 4096, 1024, E, bid, nb);
}
#define MFMA32(a, b, c) __builtin_amdgcn_mfma_f32_32x32x16_bf16((a), (b), (c), 0, 0, 0)
constexpr int A_QD = 0, A_KD = 17408, A_KLT = 34816, A_VT = 53248, A_P = 71680, A_TOT = 80896;
__device__ __forceinline__ void phase_hgrn_a(const P& p, LAS unsigned char* lds, int bid, int nb) {
  const int tid = pg8::opaque_tid(), lane = tid & 63, wid = __builtin_amdgcn_readfirstlane(tid >> 6), l31 = lane & 31, hh = lane >> 5;
  LAS bf16_t* qdL = (LAS bf16_t*)(lds + A_QD); LAS bf16_t* kdL = (LAS bf16_t*)(lds + A_KD); LAS bf16_t* klT = (LAS bf16_t*)(lds + A_KLT);
  LAS bf16_t* vT = (LAS bf16_t*)(lds + A_VT); LAS bf16_t* PL = (LAS bf16_t*)(lds + A_P); LAS float* tot = (LAS float*)(lds + A_TOT);
  bf16_t* qs = (bf16_t*)(p.ws + R_QS); const float* lf = (const float*)(p.ws + R_LF); bf16_t* vi = (bf16_t*)(p.ws + R_VI);
  bf16_t* ST = (bf16_t*)(p.ws + R_ST); float* decs = (float*)(p.ws + R_DEC);
  const int d = tid & 127, rg = tid >> 7;
  for (int ch = bid; ch < 2048; ch += nb) {
    const int n = ch & 63, h = (ch >> 6) & 7, b = ch >> 9;
    const size_t t0 = (size_t)b * SEQ + n * 64;
    const size_t g0 = (t0 + rg * 16) * 1024 + h * 128 + d;
    float lfv[16], qv[16], vv[16];
#pragma unroll
    for (int r = 0; r < 16; ++r) { lfv[r] = lf[g0 + (size_t)r * 1024]; qv[r] = bf2f(qs[g0 + (size_t)r * 1024]); vv[r] = bf2f(vi[g0 + (size_t)r * 1024]); }
    float bl[16]; float run = 0.f;
#pragma unroll
    for (int r = 0; r < 16; ++r) { run += lfv[r]; bl[r] = run; }
    tot[rg * 128 + d] = run;
    __syncthreads();
    float off = 0.f, total = 0.f;
#pragma unroll
    for (int g = 0; g < 4; ++g) { const float tg = tot[g * 128 + d]; off += (g < rg) ? tg : 0.f; total += tg; }
    unsigned klp[8], vtp[8];
#pragma unroll
    for (int r = 0; r < 16; r += 2) {
      float qd2[2], kd2[2], kl2[2];
#pragma unroll
      for (int u = 0; u < 2; ++u) { const float bb = off + bl[r + u], k = 1.0f - fast_exp(lfv[r + u]);
        qd2[u] = qv[r + u] * fast_exp(bb); kd2[u] = k * fast_exp(-bb); kl2[u] = k * fast_exp(total - bb); }
      const unsigned qq = cvt_pk_bf16(qd2[0], qd2[1]), kk = cvt_pk_bf16(kd2[0], kd2[1]);
      qdL[(rg * 16 + r) * 136 + d] = (bf16_t)(qq & 0xffffu); qdL[(rg * 16 + r + 1) * 136 + d] = (bf16_t)(qq >> 16);
      kdL[(rg * 16 + r) * 136 + d] = (bf16_t)(kk & 0xffffu); kdL[(rg * 16 + r + 1) * 136 + d] = (bf16_t)(kk >> 16);
      qs[g0 + (size_t)r * 1024] = (bf16_t)(qq & 0xffffu); qs[g0 + (size_t)(r + 1) * 1024] = (bf16_t)(qq >> 16);
      klp[r >> 1] = cvt_pk_bf16(kl2[0], kl2[1]); vtp[r >> 1] = cvt_pk_bf16(vv[r], vv[r + 1]);
    }
    *(LAS u32x4*)(klT + d * 72 + rg * 16) = (u32x4){klp[0], klp[1], klp[2], klp[3]}; *(LAS u32x4*)(klT + d * 72 + rg * 16 + 8) = (u32x4){klp[4], klp[5], klp[6], klp[7]};
    *(LAS u32x4*)(vT + d * 72 + rg * 16) = (u32x4){vtp[0], vtp[1], vtp[2], vtp[3]}; *(LAS u32x4*)(vT + d * 72 + rg * 16 + 8) = (u32x4){vtp[4], vtp[5], vtp[6], vtp[7]};
    if (rg == 0) decs[(size_t)ch * 128 + d] = fast_exp(total);
    __syncthreads();
    if (wid < 3) {
      const int jt = (wid == 2) ? 1 : 0, it = (wid == 0) ? 0 : 1;
      f32x16 c; for (int i = 0; i < 16; ++i) c[i] = 0.f;
#pragma unroll
      for (int ks = 0; ks < 8; ++ks) { const bf16x8 a = *(const LAS bf16x8*)(kdL + (jt * 32 + l31) * 136 + ks * 16 + hh * 8), bq = *(const LAS bf16x8*)(qdL + (it * 32 + l31) * 136 + ks * 16 + hh * 8);
        c = MFMA32(a, bq, c); }
      const int i = it * 32 + l31;
#pragma unroll
      for (int g = 0; g < 4; ++g) { const int j0 = jt * 32 + 8 * g + 4 * hh; float v[4];
#pragma unroll
        for (int u = 0; u < 4; ++u) v[u] = (j0 + u <= i) ? c[4 * g + u] : 0.f;
        *(LAS u32x2*)(PL + i * 72 + j0) = (u32x2){cvt_pk_bf16(v[0], v[1]), cvt_pk_bf16(v[2], v[3])}; }
    }
    { const int tbase = (wid >= 3) ? (wid - 3) * 2 : 10 + wid * 2;
#pragma unroll
      for (int tt = 0; tt < 2; ++tt) { const int tile = tbase + tt, et = tile >> 2, dt = tile & 3;
        f32x16 c; for (int i = 0; i < 16; ++i) c[i] = 0.f;
#pragma unroll
        for (int ks = 0; ks < 4; ++ks) { const bf16x8 a = *(const LAS bf16x8*)(vT + (et * 32 + l31) * 72 + ks * 16 + hh * 8), bk = *(const LAS bf16x8*)(klT + (dt * 32 + l31) * 72 + ks * 16 + hh * 8);
          c = MFMA32(a, bk, c); }
        bf16_t* dst = ST + ((size_t)ch * 128 + et * 32 + 4 * hh) * 128 + dt * 32 + l31;
#pragma unroll
        for (int g = 0; g < 4; ++g)
#pragma unroll
          for (int u = 0; u < 4; u += 2) { const unsigned w = cvt_pk_bf16(c[4 * g + u], c[4 * g + u + 1]);
            dst[(size_t)(8 * g + u) * 128] = (bf16_t)(w & 0xffffu); dst[(size_t)(8 * g + u + 1) * 128] = (bf16_t)(w >> 16); } }
    }
    __syncthreads();
    { const int it = wid >> 2, et = wid & 3;
      f32x16 c; for (int i = 0; i < 16; ++i) c[i] = 0.f;
#pragma unroll
      for (int ks = 0; ks < 4; ++ks) if (ks < 2 + 2 * it) { const bf16x8 a = *(const LAS bf16x8*)(PL + (it * 32 + l31) * 72 + ks * 16 + hh * 8), bv = *(const LAS bf16x8*)(vT + (et * 32 + l31) * 72 + ks * 16 + hh * 8);
        c = MFMA32(a, bv, c); }
      bf16_t* dst = vi + (t0 + it * 32 + 4 * hh) * 1024 + h * 128 + et * 32 + l31;
#pragma unroll
      for (int g = 0; g < 4; ++g)
#pragma unroll
        for (int u = 0; u < 4; u += 2) { const unsigned w = cvt_pk_bf16(c[4 * g + u], c[4 * g + u + 1]);
          dst[(size_t)(8 * g + u) * 1024] = (bf16_t)(w & 0xffffu); dst[(size_t)(8 * g + u + 1) * 1024] = (bf16_t)(w >> 16); }
    }
  }
}
__device__ __forceinline__ void phase_hgrn_b(const P& p, int bid, int nb) {
  bf16_t* ST = (bf16_t*)(p.ws + R_ST); const float* decs = (const float*)(p.ws + R_DEC);
  for (size_t it = (size_t)bid * NTHR + pg8::opaque_tid(); it < 131072; it += (size_t)nb * NTHR) {
    const int bh = (int)(it >> 12), quad = (int)(it & 4095), d4 = (quad & 31) * 4;
    bf16_t* base = ST + (size_t)bh * 64 * 16384 + quad * 4; const float* dbase = decs + (size_t)bh * 64 * 128 + d4;
    float s0 = 0.f, s1 = 0.f, s2 = 0.f, s3 = 0.f;
#pragma unroll 8
    for (int n = 0; n < 64; ++n) {
      const u32x2 loc = *(const u32x2*)(base + (size_t)n * 16384); const f32x4 dc = *(const f32x4*)(dbase + n * 128);
      *(u32x2*)(base + (size_t)n * 16384) = (u32x2){cvt_pk_bf16(s0, s1), cvt_pk_bf16(s2, s3)};
      s0 = s0 * dc.x + bflo(loc.x); s1 = s1 * dc.y + bfhi(loc.x); s2 = s2 * dc.z + bflo(loc.y); s3 = s3 * dc.w + bfhi(loc.y);
    }
  }
}
__device__ __forceinline__ void phase_hgrn_c(const P& p, int bid, int nb) {
  const int tid = pg8::opaque_tid(), lane = tid & 63, wid = tid >> 6, l31 = lane & 31, hh = lane >> 5;
  const bf16_t* qd = (const bf16_t*)(p.ws + R_QS); bf16_t* oi = (bf16_t*)(p.ws + R_VI); const bf16_t* gs = (const bf16_t*)(p.ws + R_GS); const bf16_t* ST = (const bf16_t*)(p.ws + R_ST);
  for (int wt = bid * 8 + wid; wt < 4096; wt += nb * 8) {
    const int ch = wt >> 1, half = wt & 1, n = ch & 63, h = (ch >> 6) & 7, b = ch >> 9;
    const size_t trow = ((size_t)b * SEQ + n * 64 + half * 32 + l31) * 1024 + h * 128;
    bf16x8 bq[8];
#pragma unroll
    for (int ks = 0; ks < 8; ++ks) bq[ks] = *(const bf16x8*)(qd + trow + ks * 16 + hh * 8);
    f32x16 acc[4];
#pragma unroll
    for (int et = 0; et < 4; ++et) {
      for (int i = 0; i < 16; ++i) acc[et][i] = 0.f;
      const bf16_t* ap = ST + ((size_t)ch * 128 + et * 32 + l31) * 128 + hh * 8;
#pragma unroll
      for (int ks = 0; ks < 8; ++ks) { const bf16x8 a = *(const bf16x8*)(ap + ks * 16); acc[et] = MFMA32(a, bq[ks], acc[et]); }
    }
    float ss = 0.f;
#pragma unroll
    for (int et = 0; et < 4; ++et)
#pragma unroll
      for (int g = 0; g < 4; ++g) { const u32x2 w = *(const u32x2*)(oi + trow + et * 32 + 8 * g + 4 * hh);
        acc[et][4 * g] += bflo(w.x); acc[et][4 * g + 1] += bfhi(w.x); acc[et][4 * g + 2] += bflo(w.y); acc[et][4 * g + 3] += bfhi(w.y);
        ss += acc[et][4 * g] * acc[et][4 * g] + acc[et][4 * g + 1] * acc[et][4 * g + 1] + acc[et][4 * g + 2] * acc[et][4 * g + 2] + acc[et][4 * g + 3] * acc[et][4 * g + 3]; }
    ss += __shfl_xor(ss, 32);
    const float r = rsqrtf(ss * (1.0f / 128.0f) + 1e-6f);
#pragma unroll
    for (int et = 0; et < 4; ++et)
#pragma unroll
      for (int g = 0; g < 4; ++g) { const int e0 = et * 32 + 8 * g + 4 * hh; const f32x4 nw = *(const f32x4*)(p.hg_norm_w + h * 128 + e0); const u32x2 gw = *(const u32x2*)(gs + trow + e0);
        const float o0 = acc[et][4 * g] * r * nw.x * bflo(gw.x), o1 = acc[et][4 * g + 1] * r * nw.y * bfhi(gw.x), o2 = acc[et][4 * g + 2] * r * nw.z * bflo(gw.y), o3 = acc[et][4 * g + 3] * r * nw.w * bfhi(gw.y);
        *(u32x2*)(oi + trow + e0) = (u32x2){cvt_pk_bf16(o0, o1), cvt_pk_bf16(o2, o3)}; }
  }
}
__device__ __forceinline__ void phase_gemm2(const P& p, LAS unsigned char* lds, int bid, int nb) {
  EpiResid E; E.res = p.x; E.z = (float*)(p.ws + R_Z);
  run_gemm(lds, (const bf16_t*)(p.ws + R_VI), (const bf16_t*)(p.ws + WS_WT_O), T, 1024, 1024, E, bid, nb);
}
__device__ __forceinline__ void phase_ln(const float* __restrict__ z, const float* __restrict__ g, const float* __restrict__ bb, float* __restrict__ hout, bf16_t* __restrict__ hb, int bid, int nb) {
  const int tid_ = pg8::opaque_tid(), lane = tid_ & 63, wid = tid_ >> 6;
  for (int t = bid * 8 + wid; t < T; t += nb * 8) {
    f32x4 v[4]; float s = 0.f;
#pragma unroll
    for (int r = 0; r < 4; ++r) { v[r] = *(const f32x4*)(z + (size_t)t * 1024 + r * 256 + lane * 4); s += (v[r].x + v[r].y) + (v[r].z + v[r].w); }
    const float mu = wave_sum(s) * (1.0f / 1024.0f); float q = 0.f;
#pragma unroll
    for (int r = 0; r < 4; ++r) { v[r] = v[r] - mu; q += (v[r].x * v[r].x + v[r].y * v[r].y) + (v[r].z * v[r].z + v[r].w * v[r].w); }
    const float rs = rsqrtf(wave_sum(q) * (1.0f / 1024.0f) + 1e-5f);
#pragma unroll
    for (int r = 0; r < 4; ++r) { const int c = r * 256 + lane * 4; const f32x4 gg = *(const f32x4*)(g + c), b4 = *(const f32x4*)(bb + c);
      const f32x4 o = v[r] * rs * gg + b4;
      *(f32x4*)(hout + (size_t)t * 1024 + c) = o;
      *(u32x2*)(hb + (size_t)t * 1024 + c) = (u32x2){cvt_pk_bf16(o.x, o.y), cvt_pk_bf16(o.z, o.w)}; }
  }
}
typedef __bf16 bf16x2_t __attribute__((ext_vector_type(2)));
__device__ __forceinline__ float dot2bf(unsigned a, unsigned b, float c) { return __builtin_amdgcn_fdot2_f32_bf16(__builtin_bit_cast(bf16x2_t, a), __builtin_bit_cast(bf16x2_t, b), c, false); }
__device__ __forceinline__ void phase_peer_scores(const P& p, int l, LAS unsigned char* lds, int bid, int nb) {
  EpiF32 E; E.C = (float*)(p.ws + R_SC); E.ldc = 2048;
  run_gemm(lds, (const bf16_t*)(p.ws + WS_HB16), (const bf16_t*)(p.ws + WS_WT_PEER) + (size_t)l * 2048 * 1024, T, 2048, 1024, E, bid, nb);
}
__device__ __forceinline__ void ins16(float (&val)[16], int (&idx)[16], float x, int i) {
  if (x > val[15]) {
    val[15] = x; idx[15] = i;
#pragma unroll
    for (int j = 15; j >= 1; --j) {
      const bool sw = val[j] > val[j - 1];
      const float va = val[j], vb = val[j - 1]; const int ia = idx[j], ib = idx[j - 1];
      val[j] = sw ? vb : va; val[j - 1] = sw ? va : vb; idx[j] = sw ? ib : ia; idx[j - 1] = sw ? ia : ib;
    }
  }
}
__device__ __forceinline__ void phase_peer_topk(const P& p, int bid, int nb) {
  const float* sc = (const float*)(p.ws + R_SC); int* eidx = (int*)(p.ws + R_EIDX); float* gate = (float*)(p.ws + R_GATE);
  for (size_t gi = (size_t)bid * NTHR + pg8::opaque_tid(); gi < (size_t)T * 8; gi += (size_t)nb * NTHR) {
    const float* q = sc + gi * 256;
    float v1[16], v2[16], vc[16]; int i1[16], i2[16], ic[16];
#pragma unroll
    for (int j = 0; j < 16; ++j) { v1[j] = -INFINITY; v2[j] = -INFINITY; vc[j] = -INFINITY; i1[j] = 0; i2[j] = 0; ic[j] = 0; }
    for (int i = 0; i < 128; i += 4) { const f32x4 a = *(const f32x4*)(q + i); ins16(v1, i1, a.x, i); ins16(v1, i1, a.y, i + 1); ins16(v1, i1, a.z, i + 2); ins16(v1, i1, a.w, i + 3); }
    for (int i = 0; i < 128; i += 4) { const f32x4 a = *(const f32x4*)(q + 128 + i); ins16(v2, i2, a.x, i); ins16(v2, i2, a.y, i + 1); ins16(v2, i2, a.z, i + 2); ins16(v2, i2, a.w, i + 3); }
#pragma unroll
    for (int a = 0; a < 16; ++a)
#pragma unroll
      for (int b = 0; b < 16; ++b) if ((a + 1) * (b + 1) <= 16) ins16(vc, ic, v1[a] + v2[b], i1[a] * 128 + i2[b]);
    float s = 0.f; float e[16];
#pragma unroll
    for (int j = 0; j < 16; ++j) { e[j] = fast_exp(vc[j] - vc[0]); s += e[j]; }
    const float inv = 1.0f / s;
#pragma unroll
    for (int j = 0; j < 16; j += 4) { *(int4*)(eidx + gi * 16 + j) = make_int4(ic[j], ic[j + 1], ic[j + 2], ic[j + 3]); *(f32x4*)(gate + gi * 16 + j) = (f32x4){e[j] * inv, e[j + 1] * inv, e[j + 2] * inv, e[j + 3] * inv}; }
  }
}
__device__ __forceinline__ void fp8x16_to_f32(const u32x4& w, float (&f)[16]) {
  const unsigned ww[4] = {w.x, w.y, w.z, w.w};
#pragma unroll
  for (int i = 0; i < 4; ++i) { const f32x2 lo = __builtin_amdgcn_cvt_pk_f32_fp8((int)ww[i], false), hi = __builtin_amdgcn_cvt_pk_f32_fp8((int)ww[i], true);
    f[4 * i] = lo.x; f[4 * i + 1] = lo.y; f[4 * i + 2] = hi.x; f[4 * i + 3] = hi.y; }
}
template <int NBATCH>
__device__ __forceinline__ void phase_peer_gather(const P& p, int l, const float* __restrict__ hin, float* __restrict__ hout, int bid, int nb) {
  const int tid_ = pg8::opaque_tid(), lane = tid_ & 63, wid = tid_ >> 6;
  const int* eidx = (const int*)(p.ws + R_EIDX); const float* gate = (const float*)(p.ws + R_GATE);
  const unsigned char* tabu = p.ws + WS_TABU + (size_t)l * 16384 * 1024; const unsigned char* tabv = p.ws + WS_TABV + (size_t)l * 16384 * 1024;
  const float* sclu = (const float*)(p.ws + WS_SCL) + l * 16384; const float* sclv = (const float*)(p.ws + WS_SCL) + 32768 + l * 16384;
  const float* g = p.ln_ffn_g + l * 1024; const float* bb = p.ln_ffn_b + l * 1024; bf16_t* hb = (bf16_t*)(p.ws + WS_HB16);
  for (int t = bid * 8 + wid; t < T; t += nb * 8) {
    float x[16];
#pragma unroll
    for (int i = 0; i < 4; ++i) { const f32x4 a = *(const f32x4*)(hin + (size_t)t * 1024 + lane * 16 + 4 * i); x[4 * i] = a.x; x[4 * i + 1] = a.y; x[4 * i + 2] = a.z; x[4 * i + 3] = a.w; }
    const int id0 = eidx[(size_t)t * 128 + lane], id1 = eidx[(size_t)t * 128 + 64 + lane];
    const float gt0 = gate[(size_t)t * 128 + lane], gt1 = gate[(size_t)t * 128 + 64 + lane];
    float acc[16];
#pragma unroll
    for (int i = 0; i < 16; ++i) acc[i] = 0.f;
    for (int p0 = 0; p0 < 128; p0 += NBATCH) {
      u32x4 ur[NBATCH], vr[NBATCH]; float su[NBATCH], sv[NBATCH];
#pragma unroll
      for (int k = 0; k < NBATCH; ++k) { const int pp = p0 + k; const int e = __builtin_amdgcn_readlane(pp < 64 ? id0 : id1, pp & 63);
        ur[k] = *(const u32x4*)(tabu + (size_t)e * 1024 + lane * 16); vr[k] = *(const u32x4*)(tabv + (size_t)e * 1024 + lane * 16);
        su[k] = sclu[e]; sv[k] = sclv[e]; }
#pragma unroll
      for (int k = 0; k < NBATCH; ++k) { const int pp = p0 + k;
        float f[16]; fp8x16_to_f32(ur[k], f);
        float d0 = 0.f, d1 = 0.f;
#pragma unroll
        for (int i = 0; i < 16; i += 2) { d0 += x[i] * f[i]; d1 += x[i + 1] * f[i + 1]; }
        const float d = wave_sum(d0 + d1) * su[k];
        const float gt = __int_as_float(__builtin_amdgcn_readlane(__float_as_int(pp < 64 ? gt0 : gt1), pp & 63));
        const float w = gt * 0.5f * d * (1.0f + erff(d * 0.70710678118f)) * sv[k];
        fp8x16_to_f32(vr[k], f);
#pragma unroll
        for (int i = 0; i < 16; ++i) acc[i] += w * f[i]; }
    }
    float s = 0.f;
#pragma unroll
    for (int i = 0; i < 16; ++i) { acc[i] += ALPHA * x[i]; s += acc[i]; }
    const float mu = wave_sum(s) * (1.0f / 1024.0f); float q = 0.f;
#pragma unroll
    for (int i = 0; i < 16; ++i) { acc[i] -= mu; q += acc[i] * acc[i]; }
    const float rs = rsqrtf(wave_sum(q) * (1.0f / 1024.0f) + 1e-5f);
    const int c = lane * 16; f32x4 o[4];
#pragma unroll
    for (int i = 0; i < 4; ++i) { const f32x4 gg = *(const f32x4*)(g + c + 4 * i), b4 = *(const f32x4*)(bb + c + 4 * i);
      o[i] = (f32x4){acc[4 * i] * rs, acc[4 * i + 1] * rs, acc[4 * i + 2] * rs, acc[4 * i + 3] * rs} * gg + b4;
      *(f32x4*)(hout + (size_t)t * 1024 + c + 4 * i) = o[i]; }
    *(u32x4*)(hb + (size_t)t * 1024 + c) = (u32x4){cvt_pk_bf16(o[0].x, o[0].y), cvt_pk_bf16(o[0].z, o[0].w), cvt_pk_bf16(o[1].x, o[1].y), cvt_pk_bf16(o[1].z, o[1].w)};
    *(u32x4*)(hb + (size_t)t * 1024 + c + 8) = (u32x4){cvt_pk_bf16(o[2].x, o[2].y), cvt_pk_bf16(o[2].z, o[2].w), cvt_pk_bf16(o[3].x, o[3].y), cvt_pk_bf16(o[3].z, o[3].w)};
  }
}
struct EpiAttn {
  static constexpr bool PERM = true, AFTER_DRAIN = false;
  unsigned char* ws; const float* cs;
  __device__ __forceinline__ void operator()(const f32x4 (&acc)[2][2][4][2], const Unit& u, int wr, int wc, int fr, int fq) const {
    const int row0 = u.pm * 256 + wr * 64 + fr;
    if (u.pn < 5) {
      const bool isq = u.pn < 4; const float scale = isq ? 0.125f : 1.0f; const int ld = isq ? 1024 : 256;
      bf16_t* dst = (bf16_t*)(ws + (isq ? R_Q : R_KB)) + (isq ? u.pn * 256 : 0) + wc * 32 + 8 * fq;
      const bool ropewave = (wc & 1) == 0;
#pragma unroll
      for (int ai = 0; ai < 2; ++ai)
#pragma unroll
        for (int m = 0; m < 4; ++m) { const int row = row0 + ai * 128 + m * 16;
          f32x4 c4[4];
          if (ropewave) {
#pragma unroll
            for (int i = 0; i < 4; ++i) c4[i] = *(const f32x4*)(cs + (size_t)row * 16 + i * 4); }
#pragma unroll
          for (int bj = 0; bj < 2; ++bj) { f32x4 v0 = acc[ai][bj][m][0], v1 = acc[ai][bj][m][1];
            if (ropewave) {
              f32x4 p0, p1;
#pragma unroll
              for (int j = 0; j < 4; ++j) { p0[j] = __shfl_xor(v0[j], 16); p1[j] = __shfl_xor(v1[j], 16); }
              const float sg = (fq == 0) ? -1.0f : 1.0f;
              if (fq < 2) {
                v0[0] = v0[0] * c4[0].x + sg * p0[0] * c4[0].y; v0[1] = v0[1] * c4[0].z + sg * p0[1] * c4[0].w; v0[2] = v0[2] * c4[1].x + sg * p0[2] * c4[1].y; v0[3] = v0[3] * c4[1].z + sg * p0[3] * c4[1].w;
                v1[0] = v1[0] * c4[2].x + sg * p1[0] * c4[2].y; v1[1] = v1[1] * c4[2].z + sg * p1[1] * c4[2].w; v1[2] = v1[2] * c4[3].x + sg * p1[2] * c4[3].y; v1[3] = v1[3] * c4[3].z + sg * p1[3] * c4[3].w;
              }
            }
            v0 = v0 * scale; v1 = v1 * scale;
            u32x4 w; w.x = cvt_pk_bf16(v0[0], v0[1]); w.y = cvt_pk_bf16(v0[2], v0[3]); w.z = cvt_pk_bf16(v1[0], v1[1]); w.w = cvt_pk_bf16(v1[2], v1[3]);
            *(u32x4*)(dst + (size_t)row * ld + bj * 128) = w; } }
    } else {
      bf16_t* vT = (bf16_t*)(ws + R_VT);
#pragma unroll
      for (int ai = 0; ai < 2; ++ai)
#pragma unroll
        for (int m = 0; m < 4; ++m) { const int row = row0 + ai * 128 + m * 16, b = row >> 12, s = row & 4095;
#pragma unroll
          for (int bj = 0; bj < 2; ++bj)
#pragma unroll
            for (int n = 0; n < 2; ++n) { const int col = bj * 128 + wc * 32 + 8 * fq + 4 * n;
              bf16_t* d0 = vT + ((size_t)(b * 4 + (col >> 6)) * 64 + (col & 63)) * 4096 + s;
              const unsigned w0 = cvt_pk_bf16(acc[ai][bj][m][n][0], acc[ai][bj][m][n][1]), w1 = cvt_pk_bf16(acc[ai][bj][m][n][2], acc[ai][bj][m][n][3]);
              d0[0] = (bf16_t)(w0 & 0xffffu); d0[4096] = (bf16_t)(w0 >> 16); d0[2 * 4096] = (bf16_t)(w1 & 0xffffu); d0[3 * 4096] = (bf16_t)(w1 >> 16); } }
    }
  }
};
__device__ __forceinline__ void phase_gemm_qkv(const P& p, LAS unsigned char* lds, int bid, int nb) {
  EpiAttn E; E.ws = p.ws; E.cs = (const float*)(p.ws + WS_CS);
  run_gemm(lds, (const bf16_t*)(p.ws + WS_HB16), (const bf16_t*)(p.ws + WS_WT_QKV), T, 1536, 1024, E, bid, nb);
}
__device__ __forceinline__ void phase_attn(const P& p, int bid, int nb) {
  const int tid_ = pg8::opaque_tid(), lane = tid_ & 63, wid = tid_ >> 6, l31 = lane & 31, hh = lane >> 5;
  const bf16_t* q = (const bf16_t*)(p.ws + R_Q); const bf16_t* kb = (const bf16_t*)(p.ws + R_KB); const bf16_t* vT = (const bf16_t*)(p.ws + R_VT); bf16_t* ao = (bf16_t*)(p.ws + R_AO);
  for (int wt = bid * 8 + wid; wt < 8192; wt += nb * 8) {
    const int qb = wt & 127, hq = (wt >> 7) & 15, b = wt >> 11, kvh = hq >> 2, i0 = qb * 32, k0 = i0 - 128;
    const float sink = p.sw_sinks[hq];
    bf16x8 bq[4];
#pragma unroll
    for (int ks = 0; ks < 4; ++ks) bq[ks] = *(const bf16x8*)(q + (size_t)(b * SEQ + i0 + l31) * 1024 + hq * 64 + ks * 16 + hh * 8);
    f32x16 s[5];
#pragma unroll
    for (int kt = 0; kt < 5; ++kt) {
      for (int i = 0; i < 16; ++i) s[kt][i] = 0.f;
      const int kb0 = k0 + kt * 32;
      if (kb0 >= 0) {
        const bf16_t* kp = kb + (size_t)(b * SEQ + kb0 + l31) * 256 + kvh * 64 + hh * 8;
#pragma unroll
        for (int ks = 0; ks < 4; ++ks) { const bf16x8 a = *(const bf16x8*)(kp + ks * 16); s[kt] = MFMA32(a, bq[ks], s[kt]); }
      }
    }
    const int qp = i0 + l31; float m = sink;
#pragma unroll
    for (int kt = 0; kt < 5; ++kt)
#pragma unroll
      for (int r = 0; r < 16; ++r) { const int kp = k0 + kt * 32 + (r & 3) + 8 * (r >> 2) + 4 * hh; const bool valid = (kp >= 0) && (kp <= qp) && (kp > qp - 128);
        s[kt][r] = valid ? s[kt][r] : -INFINITY; m = fmaxf(m, s[kt][r]); }
    m = fmaxf(m, __shfl_xor(m, 32));
    float lsum = 0.f;
#pragma unroll
    for (int kt = 0; kt < 5; ++kt)
#pragma unroll
      for (int r = 0; r < 16; ++r) { const float e = fast_exp(s[kt][r] - m); s[kt][r] = e; lsum += e; }
    lsum += __shfl_xor(lsum, 32); lsum += fast_exp(sink - m);
    f32x16 o[2];
    for (int i = 0; i < 16; ++i) { o[0][i] = 0.f; o[1][i] = 0.f; }
#pragma unroll
    for (int kt = 0; kt < 5; ++kt) {
      const int kb0 = k0 + kt * 32;
      if (kb0 >= 0) {
#pragma unroll
        for (int st = 0; st < 2; ++st) {
          u32x4 pk; pk.x = cvt_pk_bf16(s[kt][8 * st], s[kt][8 * st + 1]); pk.y = cvt_pk_bf16(s[kt][8 * st + 2], s[kt][8 * st + 3]);
          pk.z = cvt_pk_bf16(s[kt][8 * st + 4], s[kt][8 * st + 5]); pk.w = cvt_pk_bf16(s[kt][8 * st + 6], s[kt][8 * st + 7]);
          const bf16x8 pb = __builtin_bit_cast(bf16x8, pk);
#pragma unroll
          for (int et = 0; et < 2; ++et) { const bf16_t* vp = vT + ((size_t)(b * 4 + kvh) * 64 + et * 32 + l31) * 4096 + kb0 + 16 * st + 4 * hh;
            const u32x2 lo = *(const u32x2*)vp, hi = *(const u32x2*)(vp + 8);
            const bf16x8 a = __builtin_bit_cast(bf16x8, (u32x4){lo.x, lo.y, hi.x, hi.y});
            o[et] = MFMA32(a, pb, o[et]); }
        }
      }
    }
    const float inv = 1.0f / lsum;
#pragma unroll
    for (int et = 0; et < 2; ++et)
#pragma unroll
      for (int g = 0; g < 4; ++g)
        *(u32x2*)(ao + (size_t)(b * SEQ + i0 + l31) * 1024 + hq * 64 + et * 32 + 8 * g + 4 * hh) =
            (u32x2){cvt_pk_bf16(o[et][4 * g] * inv, o[et][4 * g + 1] * inv), cvt_pk_bf16(o[et][4 * g + 2] * inv, o[et][4 * g + 3] * inv)};
  }
}
__device__ __forceinline__ void phase_gemm_swo(const P& p, LAS unsigned char* lds, int bid, int nb) {
  EpiResid E; E.res = p.out; E.z = (float*)(p.ws + R_Z);
  run_gemm(lds, (const bf16_t*)(p.ws + R_AO), (const bf16_t*)(p.ws + WS_WT_SWO), T, 1024, 1024, E, bid, nb);
}
#ifndef R_PREP
#define R_PREP 1
#endif
#ifndef R_G1
#define R_G1 1
#endif
#ifndef R_HA
#define R_HA 1
#endif
#ifndef R_HB
#define R_HB 1
#endif
#ifndef R_HC
#define R_HC 1
#endif
#ifndef R_G2
#define R_G2 1
#endif
#ifndef R_LN
#define R_LN 1
#endif
#ifndef R_SC_
#define R_SC_ 1
#endif
#ifndef R_TK
#define R_TK 1
#endif
#ifndef R_GA
#define R_GA 1
#endif
#ifndef R_QKV
#define R_QKV 1
#endif
#ifndef R_AT
#define R_AT 1
#endif
#ifndef R_SWO
#define R_SWO 1
#endif
__global__ __launch_bounds__(512, 2) void mega_fwd(P p) {
  extern __shared__ __attribute__((aligned(16))) unsigned char shm[];
  LAS unsigned char* lds = (LAS unsigned char*)shm;
  cooperative_groups::grid_group grid = cooperative_groups::this_grid();
  const int bid = blockIdx.x, nb = gridDim.x;
  volatile LAS unsigned* xst = (volatile LAS unsigned*)(lds + 131072);
  if (threadIdx.x < 4) xst[threadIdx.x] = 0u;
  __syncthreads();
  const XcdBarrier xb = xcd_barrier_post((unsigned*)(p.ws + WS_CTL), xst);
  float* hA = (float*)(p.ws + WS_HA); bf16_t* hb = (bf16_t*)(p.ws + WS_HB16); const float* z = (const float*)(p.ws + R_Z);
  _Pragma("nounroll") for (int r_ = 0; r_ < R_PREP; ++r_) { phase_prep(p, lds, bid, nb); grid.sync(); }
  _Pragma("nounroll") for (int r_ = 0; r_ < R_G1; ++r_) { phase_gemm1(p, lds, bid, nb); xcd_barrier(xb); }
  _Pragma("nounroll") for (int r_ = 0; r_ < R_HA; ++r_) { phase_hgrn_a(p, lds, bid, nb); xcd_barrier(xb); }
  _Pragma("nounroll") for (int r_ = 0; r_ < R_HB; ++r_) { phase_hgrn_b(p, bid, nb); xcd_barrier(xb); }
  _Pragma("nounroll") for (int r_ = 0; r_ < R_HC; ++r_) { phase_hgrn_c(p, bid, nb); xcd_barrier(xb); }
  _Pragma("nounroll") for (int r_ = 0; r_ < R_G2; ++r_) { phase_gemm2(p, lds, bid, nb); xcd_barrier(xb); }
  _Pragma("nounroll") for (int r_ = 0; r_ < R_LN; ++r_) { phase_ln(z, p.ln_mix_g, p.ln_mix_b, hA, hb, bid, nb); xcd_barrier(xb); }
  _Pragma("nounroll") for (int r_ = 0; r_ < R_SC_; ++r_) { phase_peer_scores(p, 0, lds, bid, nb); xcd_barrier(xb); }
  _Pragma("nounroll") for (int r_ = 0; r_ < R_TK; ++r_) { phase_peer_topk(p, bid, nb); xcd_barrier(xb); }
  _Pragma("nounroll") for (int r_ = 0; r_ < R_GA; ++r_) { phase_peer_gather<16>(p, 0, hA, p.out, bid, nb); xcd_barrier(xb); }
  _Pragma("nounroll") for (int r_ = 0; r_ < R_QKV; ++r_) { phase_gemm_qkv(p, lds, bid, nb); xcd_barrier(xb); }
  _Pragma("nounroll") for (int r_ = 0; r_ < R_AT; ++r_) { phase_attn(p, bid, nb); xcd_barrier(xb); }
  _Pragma("nounroll") for (int r_ = 0; r_ < R_SWO; ++r_) { phase_gemm_swo(p, lds, bid, nb); xcd_barrier(xb); }
  _Pragma("nounroll") for (int r_ = 0; r_ < R_LN; ++r_) { phase_ln(z, p.ln_mix_g + 1024, p.ln_mix_b + 1024, hA, hb, bid, nb); xcd_barrier(xb); }
  _Pragma("nounroll") for (int r_ = 0; r_ < R_SC_; ++r_) { phase_peer_scores(p, 1, lds, bid, nb); xcd_barrier(xb); }
  _Pragma("nounroll") for (int r_ = 0; r_ < R_TK; ++r_) { phase_peer_topk(p, bid, nb); xcd_barrier(xb); }
  _Pragma("nounroll") for (int r_ = 0; r_ < R_GA; ++r_) { phase_peer_gather<16>(p, 1, hA, p.out, bid, nb); if (r_ + 1 < R_GA) xcd_barrier(xb); }
}
}

extern "C" void kernel_launch(void* const* d_in, const int* in_sizes, int n_in, void* d_out, int out_size, void* d_ws, size_t ws_size, hipStream_t stream) {
  constexpr int LDSB = 131072 + 16;
  static int grid_blocks = 0;
  if (!grid_blocks) {
    int dev = 0, cus = 0, per_cu = 0;
    hipGetDevice(&dev);
    hipDeviceGetAttribute(&cus, hipDeviceAttributeMultiprocessorCount, dev);
    hipFuncSetAttribute((const void*)mk::mega_fwd, hipFuncAttributeMaxDynamicSharedMemorySize, LDSB);
    hipOccupancyMaxActiveBlocksPerMultiprocessor(&per_cu, (const void*)mk::mega_fwd, 512, LDSB);
    if (per_cu < 1) per_cu = 1;
    if (per_cu > 1) per_cu = 1;
    grid_blocks = cus * per_cu;
  }
  mk::P p{};
  p.x = (const float*)d_in[0]; p.pos = (const int*)d_in[1]; p.hg_w_in = (const float*)d_in[2]; p.hg_lb = (const float*)d_in[3]; p.hg_norm_w = (const float*)d_in[4];
  p.hg_w_o = (const float*)d_in[5]; p.sw_w_q = (const float*)d_in[6]; p.sw_sinks = (const float*)d_in[7]; p.sw_w_o = (const float*)d_in[8]; p.w_kv = (const float*)d_in[9];
  p.peer_w_q = (const float*)d_in[10]; p.peer_sk = (const float*)d_in[11]; p.peer_u = (const float*)d_in[12]; p.peer_v = (const float*)d_in[13];
  p.ln_mix_g = (const float*)d_in[14]; p.ln_mix_b = (const float*)d_in[15]; p.ln_ffn_g = (const float*)d_in[16]; p.ln_ffn_b = (const float*)d_in[17];
  p.out = (float*)d_out; p.ws = (unsigned char*)d_ws;
  hipMemsetAsync(d_ws, 0, XCD_BAR_WORDS * 4, stream);
  void* args[] = {&p};
  hipError_t e = hipLaunchCooperativeKernel((const void*)mk::mega_fwd, dim3(grid_blocks), dim3(512), args, LDSB, stream);
  if (e != hipSuccess) fprintf(stderr, "cooperative launch failed: %s (grid %d)\n", hipGetErrorString(e), grid_blocks);
}
```

```cpp
#include <hip/hip_runtime.h>
#include <hip/hip_cooperative_groups.h>
#include <math.h>
#include <cstdio>
namespace pg8 {
__device__ __forceinline__ int opaque_tid() { int t = (int)threadIdx.x; asm volatile("" : "+v"(t)); return t; }
#define PG8_LAS __attribute__((address_space(3)))
typedef unsigned short bf16_t;
typedef short bf16x8 __attribute__((ext_vector_type(8)));
typedef float f32x4 __attribute__((ext_vector_type(4)));
typedef unsigned u32x4 __attribute__((ext_vector_type(4)));
constexpr int BM = 256, BK = 64, HALF = 128, HTB = HALF * BK * 2  , STAGE_BYTES = 8 * HTB, NXCD = 8, WGM = 8;

__host__ __device__ __forceinline__ int lds_byte(int r, int c) { const int st = (r >> 4) * 2 + (c >> 5), rr = r & 15, cc = c & 31, ob = rr * 64 + cc * 2; return st * 1024 + (ob ^ (((ob >> 9) & 1) << 5)); }
__host__ __device__ __forceinline__ void stage_rc(int b, int& R, int& C) { const int st = b / 1024, sb = b % 1024, swz = sb ^ (((sb >> 9) & 1) << 5); R = (st >> 1) * 16 + swz / 64; C = (st & 1) * 32 + (swz % 64) / 2; }
__host__ __device__ __forceinline__ int perm32(int rho) { const int n = rho >> 4, i = rho & 15; return 8 * (i >> 2) + 4 * n + (i & 3); }

struct Unit { int pm, pn; };
struct Gemm { const bf16_t* A; const bf16_t* Bt; int M, N, K; };

struct StaticOrder {
    int nM, nN, nwg, G, c;
    __host__ __device__ void init(int M, int N, int G_, int c_) { nM = M / BM; nN = N / BM; nwg = nM * nN; G = G_; c = c_; }
    __host__ __device__ bool next(int i, Unit& u) const {
        const long L = (long)i * G + c; if (L >= nwg) return false;
        int wgid = (int)L; { const int q = nwg / NXCD, r = nwg % NXCD, xcd = wgid % NXCD, off = wgid / NXCD; wgid = (xcd < r ? xcd * (q + 1) : r * (q + 1) + (xcd - r) * q) + off; }
        const int nig = WGM * nN, gid = wgid / nig, fm = gid * WGM, gsz = (nM - fm) < WGM ? (nM - fm) : WGM;
        u.pm = fm + ((wgid % nig) % gsz); u.pn = (wgid % nig) / gsz; return true;
    }
    __device__ __forceinline__ void a_ready(const Unit&) const {}
    __device__ __forceinline__ void done(const Unit&) const {}
};
typedef __bf16 bf16v2_t __attribute__((ext_vector_type(2)));
typedef float f32v2_t __attribute__((ext_vector_type(2)));
__device__ __forceinline__ unsigned cvt_pk_bf16(float lo, float hi) { const f32v2_t v = {lo, hi}; return __builtin_bit_cast(unsigned, __builtin_convertvector(v, bf16v2_t)); }
typedef float f32x2 __attribute__((ext_vector_type(2)));

template <class Epi, class Sched, bool STAMP = false>
__device__ __forceinline__ void gemm_phase(PG8_LAS unsigned char* lds, const Gemm g, const Sched& S, const Epi& E, unsigned long long* stamps) {
    const int tid = opaque_tid(), wid = __builtin_amdgcn_readfirstlane(tid >> 6), lane = tid & 63, wr = wid >> 2, wc = wid & 3, fr = lane & 15, fq = lane >> 4;
    const int K = g.K, nt = K / BK;
    int ts_lo = 0, ts_hi = 0, nts = 0; const unsigned long long rt_entry = STAMP ? (unsigned long long)wall_clock64() : 0ull;
#define PG8_STAMP() do { if (STAMP && wid == 0 && nts < 64) { const unsigned long long _c = (unsigned long long)clock64(); \
        ts_lo = (lane == nts) ? (int)(unsigned)_c : ts_lo; ts_hi = (lane == nts) ? (int)(unsigned)(_c >> 32) : ts_hi; ++nts; } } while (0)
    PG8_STAMP();
    unsigned voffA[2], voffB[2];
#pragma unroll
    for (int i = 0; i < 2; ++i) { int R, C; stage_rc(tid * 16 + i * 8192, R, C); const int Rb = Epi::PERM ? ((R & ~31) + perm32(R & 31)) : R;
        voffA[i] = (unsigned)(R * K + C) * 2u; voffB[i] = (unsigned)(Rb * K + C) * 2u; }
    const size_t kstep = (size_t)(BK * 2);
    const size_t hstep = (size_t)HALF * K * 2;
    const size_t tstep = 2 * hstep;
    const unsigned ldsw = (unsigned)wid * 1024u;
    const int aoff = lds_byte(wr * 64 + fr, fq * 8), boff = lds_byte(wc * 32 + fr, fq * 8);
#define PG8_SA(b, h) (((b) * 2 + (h)) * HTB)
#define PG8_SB(b, h) ((4 + (b) * 2 + (h)) * HTB)
#define PG8_STAGE(bufoff, gbase, voff) do { _Pragma("unroll") for (int _i = 0; _i < 2; ++_i) \
        __builtin_amdgcn_global_load_lds((const unsigned*)((const char*)(gbase) + (voff)[_i]), (PG8_LAS unsigned*)(lds + (bufoff) + ldsw + _i * 8192), 16, 0, 0); } while (0)
#define PG8_LDA(dst, b, h) do { _Pragma("unroll") for (int m = 0; m < 4; ++m) _Pragma("unroll") for (int k = 0; k < 2; ++k) dst[m][k] = *(const PG8_LAS bf16x8*)(lds + PG8_SA(b, h) + aoff + m * 2048 + k * 1024); } while (0)
#define PG8_LDB(dst, b, h) do { _Pragma("unroll") for (int n = 0; n < 2; ++n) _Pragma("unroll") for (int k = 0; k < 2; ++k) dst[n][k] = *(const PG8_LAS bf16x8*)(lds + PG8_SB(b, h) + boff + n * 2048 + k * 1024); } while (0)
#define PG8_MMA(ai, bj, At, Bt) do { __builtin_amdgcn_s_setprio(1); _Pragma("unroll") for (int m = 0; m < 4; ++m) _Pragma("unroll") for (int n = 0; n < 2; ++n) _Pragma("unroll") for (int k = 0; k < 2; ++k) \
        acc[ai][bj][m][n] = __builtin_amdgcn_mfma_f32_16x16x32_bf16(Bt[n][k], At[m][k], acc[ai][bj][m][n], 0, 0, 0); __builtin_amdgcn_s_setprio(0); } while (0)
#define PG8_WAIT_V(n) asm volatile("s_waitcnt vmcnt(" #n ")" ::: "memory")
#define PG8_WAIT_L(n) asm volatile("s_waitcnt lgkmcnt(" #n ")" ::: "memory")
#define PG8_BAR __builtin_amdgcn_s_barrier()
#define PG8_SCHED __builtin_amdgcn_sched_barrier(0)
    Unit cur, nxt; int ui = 0;
    if (!S.next(0, cur)) return;
    f32x4 acc[2][2][4][2];
#pragma unroll
    for (int a = 0; a < 2; ++a)
#pragma unroll
        for (int b = 0; b < 2; ++b)
#pragma unroll
            for (int m = 0; m < 4; ++m)
#pragma unroll
                for (int n = 0; n < 2; ++n) acc[a][b][m][n] = (f32x4){0.f, 0.f, 0.f, 0.f};
    bf16x8 At[4][2], B0[2][2], B1[2][2];
    const char* cA = (const char*)g.A + (size_t)cur.pm * tstep; const char* cB = (const char*)g.Bt + (size_t)cur.pn * tstep;
    S.a_ready(cur);
    PG8_STAGE(PG8_SB(0, 0), cB, voffB); PG8_STAGE(PG8_SA(0, 0), cA, voffA); PG8_STAGE(PG8_SB(0, 1), cB + hstep, voffB); PG8_STAGE(PG8_SA(0, 1), cA + hstep, voffA);
    if (wr == 1) PG8_BAR;
    PG8_WAIT_V(4); PG8_BAR;
    PG8_STAGE(PG8_SB(1, 0), cB + kstep, voffB); PG8_STAGE(PG8_SA(1, 0), cA + kstep, voffA); PG8_STAGE(PG8_SB(1, 1), cB + hstep + kstep, voffB);
    PG8_WAIT_V(6); PG8_BAR;
    PG8_STAMP();
    for (;;) {
        const bool has_next = S.next(ui + 1, nxt);
        const char* nA = has_next ? (const char*)g.A + (size_t)nxt.pm * tstep : cA; const char* nB = has_next ? (const char*)g.Bt + (size_t)nxt.pn * tstep : cB;
        for (int t = 0; t < nt; t += 2) {
            const bool last = (t == nt - 2);
            const char* a1 = cA + (size_t)(t + 1) * kstep;
            const char* a2 = last ? nA : cA + (size_t)(t + 2) * kstep; const char* b2 = last ? nB : cB + (size_t)(t + 2) * kstep;
            const char* a3 = a2 + kstep; const char* b3 = b2 + kstep;
            if (last && has_next) S.a_ready(nxt);
            PG8_LDB(B0, 0, 0); PG8_SCHED; PG8_LDA(At, 0, 0); PG8_STAGE(PG8_SA(1, 1), a1 + hstep, voffA);
            PG8_WAIT_L(8); PG8_BAR; PG8_WAIT_L(0); PG8_MMA(0, 0, At, B0); PG8_BAR; PG8_SCHED;
            PG8_LDB(B1, 0, 1); PG8_STAGE(PG8_SB(0, 0), b2, voffB);
            PG8_BAR; PG8_WAIT_L(0); PG8_MMA(0, 1, At, B1); PG8_BAR;
            PG8_LDA(At, 0, 1); PG8_STAGE(PG8_SA(0, 0), a2, voffA);
            PG8_BAR; PG8_WAIT_L(0); PG8_MMA(1, 0, At, B0); PG8_BAR; PG8_SCHED;
            PG8_STAGE(PG8_SB(0, 1), b2 + hstep, voffB);
            PG8_WAIT_V(6); PG8_BAR; PG8_MMA(1, 1, At, B1); PG8_BAR;
            PG8_LDB(B0, 1, 0); PG8_SCHED; PG8_LDA(At, 1, 0); PG8_STAGE(PG8_SA(0, 1), a2 + hstep, voffA);
            PG8_WAIT_L(8); PG8_BAR; PG8_WAIT_L(0); PG8_MMA(0, 0, At, B0); PG8_BAR; PG8_SCHED;
            PG8_LDB(B1, 1, 1); PG8_STAGE(PG8_SB(1, 0), b3, voffB);
            PG8_BAR; PG8_WAIT_L(0); PG8_MMA(0, 1, At, B1); PG8_BAR;
            PG8_LDA(At, 1, 1); PG8_STAGE(PG8_SA(1, 0), a3, voffA);
            PG8_BAR; PG8_WAIT_L(0); PG8_MMA(1, 0, At, B0); PG8_BAR; PG8_SCHED;
            PG8_STAGE(PG8_SB(1, 1), b3 + hstep, voffB);
            PG8_WAIT_V(6); PG8_BAR; PG8_MMA(1, 1, At, B1); PG8_BAR;
        }
        PG8_STAMP();
        if constexpr (!Epi::AFTER_DRAIN) { E(acc, cur, wr, wc, fr, fq); S.done(cur); }
        PG8_STAMP();
        if (!has_next) break;
#pragma unroll
        for (int a = 0; a < 2; ++a)
#pragma unroll
            for (int b = 0; b < 2; ++b)
#pragma unroll
                for (int m = 0; m < 4; ++m)
#pragma unroll
                    for (int n = 0; n < 2; ++n) acc[a][b][m][n] = (f32x4){0.f, 0.f, 0.f, 0.f};
        cur = nxt; cA = nA; cB = nB; ++ui;
    }
    PG8_WAIT_V(0);
    if (wr == 0) PG8_BAR;
    PG8_BAR;
    if constexpr (Epi::AFTER_DRAIN) { E.fused(acc, cur, wr, wc, fr, fq, lds, wid, lane); S.done(cur); }
    PG8_STAMP();
    if (STAMP && wid == 0) { stamps[lane] = lane < nts ? (((unsigned long long)(unsigned)ts_hi << 32) | (unsigned)ts_lo) : 0ull;
        if (lane == 62) stamps[62] = rt_entry; if (lane == 63) stamps[63] = (unsigned long long)wall_clock64(); }
#undef PG8_STAMP
#undef PG8_SA
#undef PG8_SB
#undef PG8_STAGE
#undef PG8_LDA
#undef PG8_LDB
#undef PG8_MMA
#undef PG8_WAIT_V
#undef PG8_WAIT_L
#undef PG8_BAR
#undef PG8_SCHED
}
}
namespace mk {
using pg8::bf16_t; using pg8::f32x4; using pg8::u32x4; using pg8::bf16x8; using pg8::Unit; using pg8::cvt_pk_bf16;
#define LAS __attribute__((address_space(3)))
typedef unsigned u32x2 __attribute__((ext_vector_type(2)));
typedef float f32x16 __attribute__((ext_vector_type(16)));
constexpr int T = 16384, D = 1024, SEQ = 4096, NTHR = 512;
constexpr float ALPHA = 1.41421356237f;
constexpr size_t MB = (size_t)1 << 20;
constexpr size_t WS_CTL = 0, WS_LBV = 1 * MB, WS_CS = 2 * MB, WS_WT_IN = 4 * MB, WS_WT_O = 12 * MB, WS_WT_QKV = 14 * MB, WS_WT_SWO = 17 * MB, WS_WT_PEER = 19 * MB,
                 WS_SCL = 3 * MB, WS_TABU = 32 * MB, WS_TABV = 64 * MB, WS_HA = 160 * MB, WS_HB16 = 224 * MB, WS_R3 = 256 * MB;
constexpr size_t R_QS = WS_R3, R_LF = WS_R3 + 32 * MB, R_VI = WS_R3 + 96 * MB, R_GS = WS_R3 + 128 * MB, R_ST = WS_R3 + 160 * MB, R_DEC = WS_R3 + 224 * MB, R_Z = WS_R3 + 160 * MB;
constexpr size_t R_SC = WS_R3, R_EIDX = WS_R3 + 128 * MB, R_GATE = WS_R3 + 136 * MB;
constexpr size_t R_Q = WS_R3, R_KB = WS_R3 + 32 * MB, R_VT = WS_R3 + 40 * MB, R_AO = WS_R3 + 48 * MB;

struct P {
  const float* x; const int* pos; const float *hg_w_in, *hg_lb, *hg_norm_w, *hg_w_o, *sw_w_q, *sw_sinks, *sw_w_o, *w_kv, *peer_w_q, *peer_sk, *peer_u, *peer_v,
      *ln_mix_g, *ln_mix_b, *ln_ffn_g, *ln_ffn_b;
  float* out; unsigned char* ws;
};

__device__ __forceinline__ float bf2f(unsigned short b) { return __uint_as_float(((unsigned)b) << 16); }
__device__ __forceinline__ float bflo(unsigned w) { return __uint_as_float(w << 16); }
__device__ __forceinline__ float bfhi(unsigned w) { return __uint_as_float(w & 0xffff0000u); }
__device__ __forceinline__ float fast_exp(float x) { return __builtin_amdgcn_exp2f(x * 1.44269504089f); }
__device__ __forceinline__ float fast_rcp(float x) { return __builtin_amdgcn_rcpf(x); }
__device__ __forceinline__ float fast_sigmoid(float x) { return fast_rcp(1.0f + fast_exp(-x)); }
__device__ __forceinline__ float fast_silu(float x) { return x * fast_sigmoid(x); }
__device__ __forceinline__ float wave_sum(float v) {
#pragma unroll
  for (int o = 1; o < 64; o <<= 1) v += __shfl_xor(v, o);
  return v;
}
typedef float f32x2 __attribute__((ext_vector_type(2)));
__device__ __forceinline__ unsigned pk4_fp8(float a, float b, float c, float d) { int w = 0; w = __builtin_amdgcn_cvt_pk_fp8_f32(a, b, w, false); w = __builtin_amdgcn_cvt_pk_fp8_f32(c, d, w, true); return (unsigned)w; }
#define XB_TMO      128
#define XB_XCNT(j)  (256  + 64 * (j))
#define XB_XSUB(j)  (1280 + 64 * (j))
#define XB_XGEN(j)  (2304 + 64 * (j))
#define XB_TOP      3328
#define XB_TOPGEN   3392
#define XCD_BAR_WORDS 3456
#define XB_SPIN_CAP (1u << 18)


__device__ __forceinline__ unsigned xb_ld(unsigned* p)              { return __hip_atomic_load(p, __ATOMIC_RELAXED, __HIP_MEMORY_SCOPE_AGENT); }
__device__ __forceinline__ unsigned xb_add(unsigned* p, unsigned v) { return __hip_atomic_fetch_add(p, v, __ATOMIC_RELAXED, __HIP_MEMORY_SCOPE_AGENT); }
__device__ __forceinline__ unsigned xb_xcc_id() { return (unsigned)__builtin_amdgcn_s_getreg((3 << 11) | 20) & 0xFu; }
#define XB_SPIN(cond, bar) do { unsigned _sp = 0; while (cond) { __builtin_amdgcn_s_sleep(1); \
    if ((++_sp & 255u) == 0u) { if (xb_ld(&(bar)[XB_TMO])) break; if (_sp > XB_SPIN_CAP) { atomicAdd(&(bar)[XB_TMO], 1u); break; } } } } while (0)

struct XcdBarrier {
    unsigned* bar; unsigned x;
    volatile LAS unsigned* st;
};

__device__ __forceinline__ XcdBarrier xcd_barrier_post(unsigned* bar, volatile LAS unsigned* st) {
    XcdBarrier b; b.bar = bar; b.x = xb_xcc_id(); b.st = st;
    if (threadIdx.x == 0) (void)xb_add(&bar[XB_XCNT(b.x)], 1u);
    return b;
}
__device__ __forceinline__ void xcd_barrier_complete(unsigned* bar, unsigned x, unsigned& nloc, unsigned& nx) {
    const unsigned G = gridDim.x * gridDim.y * gridDim.z;
    unsigned sum, cnt, mine, sp = 0u;
    for (;;) {
        sum = 0u; cnt = 0u; mine = 0u;
#pragma unroll
        for (unsigned j = 0; j < 16; ++j) { const unsigned c = xb_ld(&bar[XB_XCNT(j)]); sum += c; cnt += (c > 0u) ? 1u : 0u; mine = (j == x) ? c : mine; }
        if (sum == G) break;
        __builtin_amdgcn_s_sleep(1);
        if ((++sp & 255u) == 0u) { if (xb_ld(&bar[XB_TMO])) break; if (sp > XB_SPIN_CAP) { atomicAdd(&bar[XB_TMO], 1u); break; } }
    }
    nloc = mine > 0u ? mine : 1u; nx = cnt > 0u ? cnt : 1u;
}

__device__ __forceinline__ void xcd_barrier(const XcdBarrier& b) {
    asm volatile("s_waitcnt vmcnt(0)" ::: "memory");
    __syncthreads();
    if (threadIdx.x == 0) {
        unsigned* bar = b.bar;
        __builtin_amdgcn_s_waitcnt(0);
        unsigned nloc = b.st[0], nx = b.st[1];
        if (nloc == 0u) { xcd_barrier_complete(bar, b.x, nloc, nx); b.st[0] = nloc; b.st[1] = nx; }
        const unsigned old = xb_add(&bar[XB_XSUB(b.x)], 1u);
        const unsigned gen = old / nloc;
        if (old + 1u == (gen + 1u) * nloc) {
            __builtin_amdgcn_fence(__ATOMIC_RELEASE, "agent");
            asm volatile("s_waitcnt vmcnt(0)" ::: "memory");
            const unsigned og = xb_add(&bar[XB_TOP], 1u);
            const unsigned tg = og / nx;
            if (og + 1u == (tg + 1u) * nx) xb_add(&bar[XB_TOPGEN], 1u);
            else XB_SPIN(xb_ld(&bar[XB_TOPGEN]) == tg, bar);
            __builtin_amdgcn_fence(__ATOMIC_ACQUIRE, "agent");
            xb_add(&bar[XB_XGEN(b.x)], 1u);
            asm volatile("s_waitcnt vmcnt(0)" ::: "memory");
        } else {
            XB_SPIN(xb_ld(&bar[XB_XGEN(b.x)]) == gen, bar);
            __builtin_amdgcn_fence(__ATOMIC_ACQUIRE, "agent");
            asm volatile("s_waitcnt vmcnt(0)" ::: "memory");
        }
    }
    __syncthreads();
}
__device__ __forceinline__ void cvt_stream(const float* __restrict__ src, bf16_t* __restrict__ dst, size_t n, size_t gtid, size_t gthreads) {
  const size_t n8 = n >> 3;
  for (size_t i = gtid; i < n8; i += gthreads) {
    const f32x4 a = ((const f32x4*)src)[2 * i], b = ((const f32x4*)src)[2 * i + 1];
    u32x4 o; o.x = cvt_pk_bf16(a.x, a.y); o.y = cvt_pk_bf16(a.z, a.w); o.z = cvt_pk_bf16(b.x, b.y); o.w = cvt_pk_bf16(b.z, b.w);
    ((u32x4*)dst)[i] = o;
  }
}
__device__ __forceinline__ void cvt_rows_fp8(const float* __restrict__ src, unsigned char* __restrict__ dst, float* __restrict__ scl, int nrows, int gw, int ngw, int lane) {
  for (int r = gw; r < nrows; r += ngw) {
    const float* s = src + (size_t)r * 1024 + lane * 16;
    f32x4 v[4]; float m = 0.f;
#pragma unroll
    for (int i = 0; i < 4; ++i) { v[i] = *(const f32x4*)(s + 4 * i); m = fmaxf(fmaxf(m, fmaxf(fabsf(v[i].x), fabsf(v[i].y))), fmaxf(fabsf(v[i].z), fabsf(v[i].w))); }
#pragma unroll
    for (int o = 1; o < 64; o <<= 1) m = fmaxf(m, __shfl_xor(m, o));
    const float sc = m > 0.f ? 440.0f / m : 1.0f;
    u32x4 o4;
    o4.x = pk4_fp8(v[0].x * sc, v[0].y * sc, v[0].z * sc, v[0].w * sc); o4.y = pk4_fp8(v[1].x * sc, v[1].y * sc, v[1].z * sc, v[1].w * sc);
    o4.z = pk4_fp8(v[2].x * sc, v[2].y * sc, v[2].z * sc, v[2].w * sc); o4.w = pk4_fp8(v[3].x * sc, v[3].y * sc, v[3].z * sc, v[3].w * sc);
    *(u32x4*)(dst + (size_t)r * 1024 + lane * 16) = o4;
    if (lane == 0) scl[r] = m > 0.f ? m * (1.0f / 440.0f) : 1.0f;
  }
}
__device__ __forceinline__ void transpose_tile(const float* __restrict__ W, int K, int N, bf16_t* __restrict__ Wt, int row_off, int tile, LAS float* scr, int tid) {
  const int ntn = N / 64, kb = tile / ntn, nbk = tile % ntn, k0 = kb * 64, n0 = nbk * 64;
  { const int k = tid >> 3, n8 = (tid & 7) * 8;
    const f32x4 a = *(const f32x4*)(W + (size_t)(k0 + k) * N + n0 + n8), b = *(const f32x4*)(W + (size_t)(k0 + k) * N + n0 + n8 + 4);
    LAS float* s = scr + k * 65 + n8; s[0] = a.x; s[1] = a.y; s[2] = a.z; s[3] = a.w; s[4] = b.x; s[5] = b.y; s[6] = b.z; s[7] = b.w; }
  __syncthreads();
  { const int n = tid >> 3, k8 = (tid & 7) * 8; const LAS float* s = scr + k8 * 65 + n;
    u32x4 o; o.x = cvt_pk_bf16(s[0], s[65]); o.y = cvt_pk_bf16(s[130], s[195]); o.z = cvt_pk_bf16(s[260], s[325]); o.w = cvt_pk_bf16(s[390], s[455]);
    *(u32x4*)(Wt + (size_t)(row_off + n0 + n) * K + k0 + k8) = o; }
  __syncthreads();
}
__device__ __forceinline__ void peer_fold_item(const P& p, int item, LAS float* lds, int tid) {
  const int kt = item & 15, hc = (item >> 4) & 15, l = item >> 8, k0 = kt * 64;
  LAS float* sks = lds;
  LAS float* wqs = lds + 128 * 132;
  const float* SK = p.peer_sk + ((size_t)l * 16 + hc) * 128 * 128;
  const float* WQ = p.peer_w_q + (size_t)l * 1024 * 2048 + hc * 128;
  { const int key = tid & 127, dq = tid >> 7;
#pragma unroll
    for (int j = 0; j < 8; ++j) { const int d4 = (dq + 4 * j) * 4; const f32x4 v = *(const f32x4*)(SK + key * 128 + d4);
      sks[(d4 + 0) * 132 + key] = v.x; sks[(d4 + 1) * 132 + key] = v.y; sks[(d4 + 2) * 132 + key] = v.z; sks[(d4 + 3) * 132 + key] = v.w; } }
  { const int k = tid & 63, dq = tid >> 6;
#pragma unroll
    for (int j = 0; j < 4; ++j) { const int d4 = (dq + 8 * j) * 4; const f32x4 v = *(const f32x4*)(WQ + (size_t)(k0 + k) * 2048 + d4);
      wqs[(d4 + 0) * 68 + k] = v.x; wqs[(d4 + 1) * 68 + k] = v.y; wqs[(d4 + 2) * 68 + k] = v.z; wqs[(d4 + 3) * 68 + k] = v.w; } }
  __syncthreads();
  const int kq = tid & 15, keyq = tid >> 4;
  float acc[4][4];
#pragma unroll
  for (int i = 0; i < 4; ++i)
#pragma unroll
    for (int j = 0; j < 4; ++j) acc[i][j] = 0.f;
#pragma unroll 4
  for (int d = 0; d < 128; ++d) {
    const f32x4 a = *(const LAS f32x4*)(sks + d * 132 + keyq * 4), b = *(const LAS f32x4*)(wqs + d * 68 + kq * 4);
    const float av[4] = {a.x, a.y, a.z, a.w}, bv[4] = {b.x, b.y, b.z, b.w};
#pragma unroll
    for (int i = 0; i < 4; ++i)
#pragma unroll
      for (int j = 0; j < 4; ++j) acc[i][j] += av[i] * bv[j];
  }
  bf16_t* Wt = (bf16_t*)(p.ws + WS_WT_PEER) + ((size_t)l * 2048 + hc * 128) * 1024;
#pragma unroll
  for (int i = 0; i < 4; ++i) { u32x2 o; o.x = cvt_pk_bf16(acc[i][0], acc[i][1]); o.y = cvt_pk_bf16(acc[i][2], acc[i][3]);
    *(u32x2*)(Wt + (size_t)(keyq * 4 + i) * 1024 + k0 + kq * 4) = o; }
  __syncthreads();
}
__device__ __forceinline__ void phase_prep(const P& p, LAS unsigned char* lds, int bid, int nb) {
  const int tid = pg8::opaque_tid(); const size_t gtid = (size_t)bid * NTHR + tid, gth = (size_t)nb * NTHR;
  if (gtid < 1024) { const float a0 = p.hg_lb[gtid], a1 = p.hg_lb[1024 + gtid], mx = fmaxf(a0, a1), e0 = expf(a0 - mx), e1 = expf(a1 - mx); ((float*)(p.ws + WS_LBV))[gtid] = e0 / (e0 + e1); }
  for (size_t i = gtid; i < (size_t)T * 8; i += gth) { const int t = (int)(i >> 3), j = (int)(i & 7);
    const double inv = pow(500000.0, -(double)(2 * j) / 16.0), ang = (double)p.pos[t] * inv;
    ((float2*)(p.ws + WS_CS))[i] = make_float2((float)cos(ang), (float)sin(ang)); }
  LAS float* scr = (LAS float*)lds;
  constexpr int T_IN = 16 * 64, T_O = 16 * 16, T_Q = 16 * 16, T_KV = 16 * 8, T_SWO = 16 * 16, NT_ALL = T_IN + T_O + T_Q + T_KV + T_SWO;
  for (int it = bid; it < NT_ALL; it += nb) {
    int r = it;
    if (r < T_IN) { transpose_tile(p.hg_w_in, 1024, 4096, (bf16_t*)(p.ws + WS_WT_IN), 0, r, scr, tid); continue; } r -= T_IN;
    if (r < T_O) { transpose_tile(p.hg_w_o, 1024, 1024, (bf16_t*)(p.ws + WS_WT_O), 0, r, scr, tid); continue; } r -= T_O;
    if (r < T_Q) { transpose_tile(p.sw_w_q, 1024, 1024, (bf16_t*)(p.ws + WS_WT_QKV), 0, r, scr, tid); continue; } r -= T_Q;
    if (r < T_KV) { transpose_tile(p.w_kv, 1024, 512, (bf16_t*)(p.ws + WS_WT_QKV), 1024, r, scr, tid); continue; } r -= T_KV;
    transpose_tile(p.sw_w_o, 1024, 1024, (bf16_t*)(p.ws + WS_WT_SWO), 0, r, scr, tid);
  }
  for (int it = bid; it < 512; it += nb) peer_fold_item(p, it, scr, tid);
  cvt_stream(p.x, (bf16_t*)(p.ws + WS_HB16), (size_t)T * D, gtid, gth);
  cvt_rows_fp8(p.peer_u, p.ws + WS_TABU, (float*)(p.ws + WS_SCL), 32768, bid * 8 + (tid >> 6), nb * 8, tid & 63);
  cvt_rows_fp8(p.peer_v, p.ws + WS_TABV, (float*)(p.ws + WS_SCL) + 32768, 32768, bid * 8 + (tid >> 6), nb * 8, tid & 63);
}
struct EpiHgrn {
  static constexpr bool PERM = true, AFTER_DRAIN = false;
  unsigned char* ws; float* lf; const float* lbv;
  __device__ __forceinline__ void operator()(const f32x4 (&acc)[2][2][4][2], const Unit& u, int wr, int wc, int fr, int fq) const {
    const int sec = u.pn >> 2, row0 = u.pm * 256 + wr * 64 + fr, col0 = (u.pn & 3) * 256 + wc * 32 + 8 * fq;
    if (sec == 1) {
      float lb[2][8];
#pragma unroll
      for (int bj = 0; bj < 2; ++bj) { const f32x4 a = *(const f32x4*)(lbv + col0 + bj * 128), b = *(const f32x4*)(lbv + col0 + bj * 128 + 4);
        lb[bj][0] = a.x; lb[bj][1] = a.y; lb[bj][2] = a.z; lb[bj][3] = a.w; lb[bj][4] = b.x; lb[bj][5] = b.y; lb[bj][6] = b.z; lb[bj][7] = b.w; }
#pragma unroll
      for (int ai = 0; ai < 2; ++ai)
#pragma unroll
        for (int m = 0; m < 4; ++m) { float* rowp = lf + (size_t)(row0 + ai * 128 + m * 16) * 1024 + col0;
#pragma unroll
          for (int bj = 0; bj < 2; ++bj) { f32x4 o[2];
#pragma unroll
            for (int n = 0; n < 2; ++n)
#pragma unroll
              for (int j = 0; j < 4; ++j) { const float l = lb[bj][4 * n + j]; o[n][j] = __logf(l + (1.0f - l) * fast_sigmoid(acc[ai][bj][m][n][j])); }
            *(f32x4*)(rowp + bj * 128) = o[0]; *(f32x4*)(rowp + bj * 128 + 4) = o[1]; } }
    } else {
      const size_t doff = sec == 0 ? R_QS : (sec == 2 ? R_VI : R_GS);
      bf16_t* dst = (bf16_t*)(ws + doff);
#pragma unroll
      for (int ai = 0; ai < 2; ++ai)
#pragma unroll
        for (int m = 0; m < 4; ++m) { bf16_t* rowp = dst + (size_t)(row0 + ai * 128 + m * 16) * 1024 + col0;
#pragma unroll
          for (int bj = 0; bj < 2; ++bj) { f32x4 v0 = acc[ai][bj][m][0], v1 = acc[ai][bj][m][1];
            if (sec != 2) {
#pragma unroll
              for (int j = 0; j < 4; ++j) { v0[j] = fast_silu(v0[j]); v1[j] = fast_silu(v1[j]); } }
            u32x4 w; w.x = cvt_pk_bf16(v0[0], v0[1]); w.y = cvt_pk_bf16(v0[2], v0[3]); w.z = cvt_pk_bf16(v1[0], v1[1]); w.w = cvt_pk_bf16(v1[2], v1[3]);
            *(u32x4*)(rowp + bj * 128) = w; } }
    }
  }
};
struct EpiResid {
  static constexpr bool PERM = false, AFTER_DRAIN = false;
  const float* res; float* z;
  __device__ __forceinline__ void operator()(const f32x4 (&acc)[2][2][4][2], const Unit& u, int wr, int wc, int fr, int fq) const {
    const int row0 = u.pm * 256 + wr * 64 + fr, col0 = u.pn * 256 + wc * 32 + 4 * fq;
#pragma unroll
    for (int ai = 0; ai < 2; ++ai)
#pragma unroll
      for (int m = 0; m < 4; ++m) { const size_t off = (size_t)(row0 + ai * 128 + m * 16) * 1024 + col0;
#pragma unroll
        for (int bj = 0; bj < 2; ++bj)
#pragma unroll
          for (int n = 0; n < 2; ++n) { const f32x4 r = *(const f32x4*)(res + off + bj * 128 + n * 16); *(f32x4*)(z + off + bj * 128 + n * 16) = acc[ai][bj][m][n] + ALPHA * r; } }
  }
};
struct EpiF32 {
  static constexpr bool PERM = false, AFTER_DRAIN = false;
  float* C; int ldc;
  __device__ __forceinline__ void operator()(const f32x4 (&acc)[2][2][4][2], const Unit& u, int wr, int wc, int fr, int fq) const {
    const int row0 = u.pm * 256 + wr * 64 + fr, col0 = u.pn * 256 + wc * 32 + 4 * fq;
#pragma unroll
    for (int ai = 0; ai < 2; ++ai)
#pragma unroll
      for (int m = 0; m < 4; ++m) { float* rowp = C + (size_t)(row0 + ai * 128 + m * 16) * ldc + col0;
#pragma unroll
        for (int bj = 0; bj < 2; ++bj)
#pragma unroll
          for (int n = 0; n < 2; ++n) *(f32x4*)(rowp + bj * 128 + n * 16) = acc[ai][bj][m][n]; }
  }
};

template <class Epi>
__device__ __forceinline__ void run_gemm(LAS unsigned char* lds, const bf16_t* A, const bf16_t* Bt, int M, int N, int K, const Epi& E, int bid, int nb) {
  pg8::Gemm g; g.A = A; g.Bt = Bt; g.M = M; g.N = N; g.K = K;
  pg8::StaticOrder S; S.init(M, N, nb, bid);
  pg8::gemm_phase<Epi, pg8::StaticOrder, false>(lds, g, S, E, nullptr);
}
__device__ __forceinline__ void phase_gemm1(const P& p, LAS unsigned char* lds, int bid, int nb) {
  EpiHgrn E; E.ws = p.ws; E.lf = (float*)(p.ws + R_LF); E.lbv = (const float*)(p.ws + WS_LBV);
  run_gemm(lds, (const bf16_t*)(p.ws + WS_HB16), (const bf16_t*)(p.ws + WS_WT_IN), T, 4096, 1024, E, bid, nb);
}
#define MFMA32(a, b, c) __builtin_amdgcn_mfma_f32_32x32x16_bf16((a), (b), (c), 0, 0, 0)
constexpr int A_QD = 0, A_KD = 17408, A_KLT = 34816, A_VT = 53248, A_P = 71680, A_TOT = 80896;
__device__ __forceinline__ void phase_hgrn_a(const P& p, LAS unsigned char* lds, int bid, int nb) {
  const int tid = pg8::opaque_tid(), lane = tid & 63, wid = __builtin_amdgcn_readfirstlane(tid >> 6), l31 = lane & 31, hh = lane >> 5;
  LAS bf16_t* qdL = (LAS bf16_t*)(lds + A_QD); LAS bf16_t* kdL = (LAS bf16_t*)(lds + A_KD); LAS bf16_t* klT = (LAS bf16_t*)(lds + A_KLT);
  LAS bf16_t* vT = (LAS bf16_t*)(lds + A_VT); LAS bf16_t* PL = (LAS bf16_t*)(lds + A_P); LAS float* tot = (LAS float*)(lds + A_TOT);
  bf16_t* qs = (bf16_t*)(p.ws + R_QS); const float* lf = (const float*)(p.ws + R_LF); bf16_t* vi = (bf16_t*)(p.ws + R_VI);
  bf16_t* ST = (bf16_t*)(p.ws + R_ST); float* decs = (float*)(p.ws + R_DEC);
  const int d = tid & 127, rg = tid >> 7;
  for (int ch = bid; ch < 2048; ch += nb) {
    const int n = ch & 63, h = (ch >> 6) & 7, b = ch >> 9;
    const size_t t0 = (size_t)b * SEQ + n * 64;
    const size_t g0 = (t0 + rg * 16) * 1024 + h * 128 + d;
    float lfv[16], qv[16], vv[16];
#pragma unroll
    for (int r = 0; r < 16; ++r) { lfv[r] = lf[g0 + (size_t)r * 1024]; qv[r] = bf2f(qs[g0 + (size_t)r * 1024]); vv[r] = bf2f(vi[g0 + (size_t)r * 1024]); }
    float bl[16]; float run = 0.f;
#pragma unroll
    for (int r = 0; r < 16; ++r) { run += lfv[r]; bl[r] = run; }
    tot[rg * 128 + d] = run;
    __syncthreads();
    float off = 0.f, total = 0.f;
#pragma unroll
    for (int g = 0; g < 4; ++g) { const float tg = tot[g * 128 + d]; off += (g < rg) ? tg : 0.f; total += tg; }
    unsigned klp[8], vtp[8];
#pragma unroll
    for (int r = 0; r < 16; r += 2) {
      float qd2[2], kd2[2], kl2[2];
#pragma unroll
      for (int u = 0; u < 2; ++u) { const float bb = off + bl[r + u], k = 1.0f - fast_exp(lfv[r + u]);
        qd2[u] = qv[r + u] * fast_exp(bb); kd2[u] = k * fast_exp(-bb); kl2[u] = k * fast_exp(total - bb); }
      const unsigned qq = cvt_pk_bf16(qd2[0], qd2[1]), kk = cvt_pk_bf16(kd2[0], kd2[1]);
      qdL[(rg * 16 + r) * 136 + d] = (bf16_t)(qq & 0xffffu); qdL[(rg * 16 + r + 1) * 136 + d] = (bf16_t)(qq >> 16);
      kdL[(rg * 16 + r) * 136 + d] = (bf16_t)(kk & 0xffffu); kdL[(rg * 16 + r + 1) * 136 + d] = (bf16_t)(kk >> 16);
      qs[g0 + (size_t)r * 1024] = (bf16_t)(qq & 0xffffu); qs[g0 + (size_t)(r + 1) * 1024] = (bf16_t)(qq >> 16);
      klp[r >> 1] = cvt_pk_bf16(kl2[0], kl2[1]); vtp[r >> 1] = cvt_pk_bf16(vv[r], vv[r + 1]);
    }
    *(LAS u32x4*)(klT + d * 72 + rg * 16) = (u32x4){klp[0], klp[1], klp[2], klp[3]}; *(LAS u32x4*)(klT + d * 72 + rg * 16 + 8) = (u32x4){klp[4], klp[5], klp[6], klp[7]};
    *(LAS u32x4*)(vT + d * 72 + rg * 16) = (u32x4){vtp[0], vtp[1], vtp[2], vtp[3]}; *(LAS u32x4*)(vT + d * 72 + rg * 16 + 8) = (u32x4){vtp[4], vtp[5], vtp[6], vtp[7]};
    if (rg == 0) decs[(size_t)ch * 128 + d] = fast_exp(total);
    __syncthreads();
    if (wid < 3) {
      const int jt = (wid == 2) ? 1 : 0, it = (wid == 0) ? 0 : 1;
      f32x16 c; for (int i = 0; i < 16; ++i) c[i] = 0.f;
#pragma unroll
      for (int ks = 0; ks < 8; ++ks) { const bf16x8 a = *(const LAS bf16x8*)(kdL + (jt * 32 + l31) * 136 + ks * 16 + hh * 8), bq = *(const LAS bf16x8*)(qdL + (it * 32 + l31) * 136 + ks * 16 + hh * 8);
        c = MFMA32(a, bq, c); }
      const int i = it * 32 + l31;
#pragma unroll
      for (int g = 0; g < 4; ++g) { const int j0 = jt * 32 + 8 * g + 4 * hh; float v[4];
#pragma unroll
        for (int u = 0; u < 4; ++u) v[u] = (j0 + u <= i) ? c[4 * g + u] : 0.f;
        *(LAS u32x2*)(PL + i * 72 + j0) = (u32x2){cvt_pk_bf16(v[0], v[1]), cvt_pk_bf16(v[2], v[3])}; }
    }
    { const int tbase = (wid >= 3) ? (wid - 3) * 2 : 10 + wid * 2;
#pragma unroll
      for (int tt = 0; tt < 2; ++tt) { const int tile = tbase + tt, et = tile >> 2, dt = tile & 3;
        f32x16 c; for (int i = 0; i < 16; ++i) c[i] = 0.f;
#pragma unroll
        for (int ks = 0; ks < 4; ++ks) { const bf16x8 a = *(const LAS bf16x8*)(vT + (et * 32 + l31) * 72 + ks * 16 + hh * 8), bk = *(const LAS bf16x8*)(klT + (dt * 32 + l31) * 72 + ks * 16 + hh * 8);
          c = MFMA32(a, bk, c); }
        bf16_t* dst = ST + ((size_t)ch * 128 + et * 32 + 4 * hh) * 128 + dt * 32 + l31;
#pragma unroll
        for (int g = 0; g < 4; ++g)
#pragma unroll
          for (int u = 0; u < 4; u += 2) { const unsigned w = cvt_pk_bf16(c[4 * g + u], c[4 * g + u + 1]);
            dst[(size_t)(8 * g + u) * 128] = (bf16_t)(w & 0xffffu); dst[(size_t)(8 * g + u + 1) * 128] = (bf16_t)(w >> 16); } }
    }
    __syncthreads();
    { const int it = wid >> 2, et = wid & 3;
      f32x16 c; for (int i = 0; i < 16; ++i) c[i] = 0.f;
#pragma unroll
      for (int ks = 0; ks < 4; ++ks) if (ks < 2 + 2 * it) { const bf16x8 a = *(const LAS bf16x8*)(PL + (it * 32 + l31) * 72 + ks * 16 + hh * 8), bv = *(const LAS bf16x8*)(vT + (et * 32 + l31) * 72 + ks * 16 + hh * 8);
        c = MFMA32(a, bv, c); }
      bf16_t* dst = vi + (t0 + it * 32 + 4 * hh) * 1024 + h * 128 + et * 32 + l31;
#pragma unroll
      for (int g = 0; g < 4; ++g)
#pragma unroll
        for (int u = 0; u < 4; u += 2) { const unsigned w = cvt_pk_bf16(c[4 * g + u], c[4 * g + u + 1]);
          dst[(size_t)(8 * g + u) * 1024] = (bf16_t)(w & 0xffffu); dst[(size_t)(8 * g + u + 1) * 1024] = (bf16_t)(w >> 16); }
    }
  }
}
__device__ __forceinline__ void phase_hgrn_b(const P& p, int bid, int nb) {
  bf16_t* ST = (bf16_t*)(p.ws + R_ST); const float* decs = (const float*)(p.ws + R_DEC);
  for (size_t it = (size_t)bid * NTHR + pg8::opaque_tid(); it < 131072; it += (size_t)nb * NTHR) {
    const int bh = (int)(it >> 12), quad = (int)(it & 4095), d4 = (quad & 31) * 4;
    bf16_t* base = ST + (size_t)bh * 64 * 16384 + quad * 4; const float* dbase = decs + (size_t)bh * 64 * 128 + d4;
    float s0 = 0.f, s1 = 0.f, s2 = 0.f, s3 = 0.f;
#pragma unroll 8
    for (int n = 0; n < 64; ++n) {
      const u32x2 loc = *(const u32x2*)(base + (size_t)n * 16384); const f32x4 dc = *(const f32x4*)(dbase + n * 128);
      *(u32x2*)(base + (size_t)n * 16384) = (u32x2){cvt_pk_bf16(s0, s1), cvt_pk_bf16(s2, s3)};
      s0 = s0 * dc.x + bflo(loc.x); s1 = s1 * dc.y + bfhi(loc.x); s2 = s2 * dc.z + bflo(loc.y); s3 = s3 * dc.w + bfhi(loc.y);
    }
  }
}
__device__ __forceinline__ void phase_hgrn_c(const P& p, int bid, int nb) {
  const int tid = pg8::opaque_tid(), lane = tid & 63, wid = tid >> 6, l31 = lane & 31, hh = lane >> 5;
  const bf16_t* qd = (const bf16_t*)(p.ws + R_QS); bf16_t* oi = (bf16_t*)(p.ws + R_VI); const bf16_t* gs = (const bf16_t*)(p.ws + R_GS); const bf16_t* ST = (const bf16_t*)(p.ws + R_ST);
  for (int wt = bid * 8 + wid; wt < 4096; wt += nb * 8) {
    const int ch = wt >> 1, half = wt & 1, n = ch & 63, h = (ch >> 6) & 7, b = ch >> 9;
    const size_t trow = ((size_t)b * SEQ + n * 64 + half * 32 + l31) * 1024 + h * 128;
    bf16x8 bq[8];
#pragma unroll
    for (int ks = 0; ks < 8; ++ks) bq[ks] = *(const bf16x8*)(qd + trow + ks * 16 + hh * 8);
    f32x16 acc[4];
#pragma unroll
    for (int et = 0; et < 4; ++et) {
      for (int i = 0; i < 16; ++i) acc[et][i] = 0.f;
      const bf16_t* ap = ST + ((size_t)ch * 128 + et * 32 + l31) * 128 + hh * 8;
#pragma unroll
      for (int ks = 0; ks < 8; ++ks) { const bf16x8 a = *(const bf16x8*)(ap + ks * 16); acc[et] = MFMA32(a, bq[ks], acc[et]); }
    }
    float ss = 0.f;
#pragma unroll
    for (int et = 0; et < 4; ++et)
#pragma unroll
      for (int g = 0; g < 4; ++g) { const u32x2 w = *(const u32x2*)(oi + trow + et * 32 + 8 * g + 4 * hh);
        acc[et][4 * g] += bflo(w.x); acc[et][4 * g + 1] += bfhi(w.x); acc[et][4 * g + 2] += bflo(w.y); acc[et][4 * g + 3] += bfhi(w.y);
        ss += acc[et][4 * g] * acc[et][4 * g] + acc[et][4 * g + 1] * acc[et][4 * g + 1] + acc[et][4 * g + 2] * acc[et][4 * g + 2] + acc[et][4 * g + 3] * acc[et][4 * g + 3]; }
    ss += __shfl_xor(ss, 32);
    const float r = rsqrtf(ss * (1.0f / 128.0f) + 1e-6f);
#pragma unroll
    for (int et = 0; et < 4; ++et)
#pragma unroll
      for (int g = 0; g < 4; ++g) { const int e0 = et * 32 + 8 * g + 4 * hh; const f32x4 nw = *(const f32x4*)(p.hg_norm_w + h * 128 + e0); const u32x2 gw = *(const u32x2*)(gs + trow + e0);
        const float o0 = acc[et][4 * g] * r * nw.x * bflo(gw.x), o1 = acc[et][4 * g + 1] * r * nw.y * bfhi(gw.x), o2 = acc[et][4 * g + 2] * r * nw.z * bflo(gw.y), o3 = acc[et][4 * g + 3] * r * nw.w * bfhi(gw.y);
        *(u32x2*)(oi + trow + e0) = (u32x2){cvt_pk_bf16(o0, o1), cvt_pk_bf16(o2, o3)}; }
  }
}
__device__ __forceinline__ void phase_gemm2(const P& p, LAS unsigned char* lds, int bid, int nb) {
  EpiResid E; E.res = p.x; E.z = (float*)(p.ws + R_Z);
  run_gemm(lds, (const bf16_t*)(p.ws + R_VI), (const bf16_t*)(p.ws + WS_WT_O), T, 1024, 1024, E, bid, nb);
}
__device__ __forceinline__ void phase_ln(const float* __restrict__ z, const float* __restrict__ g, const float* __restrict__ bb, float* __restrict__ hout, bf16_t* __restrict__ hb, int bid, int nb) {
  const int tid_ = pg8::opaque_tid(), lane = tid_ & 63, wid = tid_ >> 6;
  for (int t = bid * 8 + wid; t < T; t += nb * 8) {
    f32x4 v[4]; float s = 0.f;
#pragma unroll
    for (int r = 0; r < 4; ++r) { v[r] = *(const f32x4*)(z + (size_t)t * 1024 + r * 256 + lane * 4); s += (v[r].x + v[r].y) + (v[r].z + v[r].w); }
    const float mu = wave_sum(s) * (1.0f / 1024.0f); float q = 0.f;
#pragma unroll
    for (int r = 0; r < 4; ++r) { v[r] = v[r] - mu; q += (v[r].x * v[r].x + v[r].y * v[r].y) + (v[r].z * v[r].z + v[r].w * v[r].w); }
    const float rs = rsqrtf(wave_sum(q) * (1.0f / 1024.0f) + 1e-5f);
#pragma unroll
    for (int r = 0; r < 4; ++r) { const int c = r * 256 + lane * 4; const f32x4 gg = *(const f32x4*)(g + c), b4 = *(const f32x4*)(bb + c);
      const f32x4 o = v[r] * rs * gg + b4;
      *(f32x4*)(hout + (size_t)t * 1024 + c) = o;
      *(u32x2*)(hb + (size_t)t * 1024 + c) = (u32x2){cvt_pk_bf16(o.x, o.y), cvt_pk_bf16(o.z, o.w)}; }
  }
}
typedef __bf16 bf16x2_t __attribute__((ext_vector_type(2)));
__device__ __forceinline__ float dot2bf(unsigned a, unsigned b, float c) { return __builtin_amdgcn_fdot2_f32_bf16(__builtin_bit_cast(bf16x2_t, a), __builtin_bit_cast(bf16x2_t, b), c, false); }
__device__ __forceinline__ void phase_peer_scores(const P& p, int l, LAS unsigned char* lds, int bid, int nb) {
  EpiF32 E; E.C = (float*)(p.ws + R_SC); E.ldc = 2048;
  run_gemm(lds, (const bf16_t*)(p.ws + WS_HB16), (const bf16_t*)(p.ws + WS_WT_PEER) + (size_t)l * 2048 * 1024, T, 2048, 1024, E, bid, nb);
}
__device__ __forceinline__ void fp8x16_to_f32(const u32x4& w, float (&f)[16]) {
  const unsigned ww[4] = {w.x, w.y, w.z, w.w};
#pragma unroll
  for (int i = 0; i < 4; ++i) { const f32x2 lo = __builtin_amdgcn_cvt_pk_f32_fp8((int)ww[i], false), hi = __builtin_amdgcn_cvt_pk_f32_fp8((int)ww[i], true);
    f[4 * i] = lo.x; f[4 * i + 1] = lo.y; f[4 * i + 2] = hi.x; f[4 * i + 3] = hi.y; }
}
template <int NBATCH>
__device__ __forceinline__ void phase_peer_gather(const P& p, int l, const float* __restrict__ hin, float* __restrict__ hout, int bid, int nb) {
  const int tid_ = pg8::opaque_tid(), lane = tid_ & 63, wid = tid_ >> 6;
  const int* eidx = (const int*)(p.ws + R_EIDX); const float* gate = (const float*)(p.ws + R_GATE);
  const unsigned char* tabu = p.ws + WS_TABU + (size_t)l * 16384 * 1024; const unsigned char* tabv = p.ws + WS_TABV + (size_t)l * 16384 * 1024;
  const float* sclu = (const float*)(p.ws + WS_SCL) + l * 16384; const float* sclv = (const float*)(p.ws + WS_SCL) + 32768 + l * 16384;
  const float* g = p.ln_ffn_g + l * 1024; const float* bb = p.ln_ffn_b + l * 1024; bf16_t* hb = (bf16_t*)(p.ws + WS_HB16);
  for (int t = bid * 8 + wid; t < T; t += nb * 8) {
    float x[16];
#pragma unroll
    for (int i = 0; i < 4; ++i) { const f32x4 a = *(const f32x4*)(hin + (size_t)t * 1024 + lane * 16 + 4 * i); x[4 * i] = a.x; x[4 * i + 1] = a.y; x[4 * i + 2] = a.z; x[4 * i + 3] = a.w; }
    const int id0 = eidx[(size_t)t * 128 + lane], id1 = eidx[(size_t)t * 128 + 64 + lane];
    const float gt0 = gate[(size_t)t * 128 + lane], gt1 = gate[(size_t)t * 128 + 64 + lane];
    float acc[16];
#pragma unroll
    for (int i = 0; i < 16; ++i) acc[i] = 0.f;
    for (int p0 = 0; p0 < 128; p0 += NBATCH) {
      u32x4 ur[NBATCH], vr[NBATCH]; float su[NBATCH], sv[NBATCH];
#pragma unroll
      for (int k = 0; k < NBATCH; ++k) { const int pp = p0 + k; const int e = __builtin_amdgcn_readlane(pp < 64 ? id0 : id1, pp & 63);
        ur[k] = *(const u32x4*)(tabu + (size_t)e * 1024 + lane * 16); vr[k] = *(const u32x4*)(tabv + (size_t)e * 1024 + lane * 16);
        su[k] = sclu[e]; sv[k] = sclv[e]; }
#pragma unroll
      for (int k = 0; k < NBATCH; ++k) { const int pp = p0 + k;
        float f[16]; fp8x16_to_f32(ur[k], f);
        float d0 = 0.f, d1 = 0.f;
#pragma unroll
        for (int i = 0; i < 16; i += 2) { d0 += x[i] * f[i]; d1 += x[i + 1] * f[i + 1]; }
        const float d = wave_sum(d0 + d1) * su[k];
        const float gt = __int_as_float(__builtin_amdgcn_readlane(__float_as_int(pp < 64 ? gt0 : gt1), pp & 63));
        const float w = gt * 0.5f * d * (1.0f + erff(d * 0.70710678118f)) * sv[k];
        fp8x16_to_f32(vr[k], f);
#pragma unroll
        for (int i = 0; i < 16; ++i) acc[i] += w * f[i]; }
    }
    float s = 0.f;
#pragma unroll
    for (int i = 0; i < 16; ++i) { acc[i] += ALPHA * x[i]; s += acc[i]; }
    const float mu = wave_sum(s) * (1.0f / 1024.0f); float q = 0.f;
#pragma unroll
    for (int i = 0; i < 16; ++i) { acc[i] -= mu; q += acc[i] * acc[i]; }
    const float rs = rsqrtf(wave_sum(q) * (1.0f / 1024.0f) + 1e-5f);
    const int c = lane * 16; f32x4 o[4];
#pragma unroll
    for (int i = 0; i < 4; ++i) { const f32x4 gg = *(const f32x4*)(g + c + 4 * i), b4 = *(const f32x4*)(bb + c + 4 * i);
      o[i] = (f32x4){acc[4 * i] * rs, acc[4 * i + 1] * rs, acc[4 * i + 2] * rs, acc[4 * i + 3] * rs} * gg + b4;
      *(f32x4*)(hout + (size_t)t * 1024 + c + 4 * i) = o[i]; }
    *(u32x4*)(hb + (size_t)t * 1024 + c) = (u32x4){cvt_pk_bf16(o[0].x, o[0].y), cvt_pk_bf16(o[0].z, o[0].w), cvt_pk_bf16(o[1].x, o[1].y), cvt_pk_bf16(o[1].z, o[1].w)};
    *(u32x4*)(hb + (size_t)t * 1024 + c + 8) = (u32x4){cvt_pk_bf16(o[2].x, o[2].y), cvt_pk_bf16(o[2].z, o[2].w), cvt_pk_bf16(o[3].x, o[3].y), cvt_pk_bf16(o[3].z, o[3].w)};
  }
}
#define CE(a, b) do { const unsigned mx_ = (a) > (b) ? (a) : (b), mn_ = (a) > (b) ? (b) : (a); (a) = mx_; (b) = mn_; } while (0)
__device__ __forceinline__ unsigned f2ord(float f) { const unsigned u = __float_as_uint(f); return u ^ ((unsigned)((int)u >> 31) | 0x80000000u); }
__device__ __forceinline__ float ord2f(unsigned o) { return __uint_as_float(o ^ ((o & 0x80000000u) ? 0x80000000u : 0xffffffffu)); }
__device__ __forceinline__ void sort16_desc(unsigned (&k)[16]) { CE(k[0], k[1]); CE(k[2], k[3]); CE(k[0], k[2]); CE(k[1], k[3]); CE(k[1], k[2]); CE(k[4], k[5]); CE(k[6], k[7]); CE(k[4], k[6]); CE(k[5], k[7]); CE(k[5], k[6]); CE(k[0], k[4]); CE(k[2], k[6]); CE(k[2], k[4]); CE(k[1], k[5]); CE(k[3], k[7]); CE(k[3], k[5]); CE(k[1], k[2]); CE(k[3], k[4]); CE(k[5], k[6]); CE(k[8], k[9]); CE(k[10], k[11]); CE(k[8], k[10]); CE(k[9], k[11]); CE(k[9], k[10]); CE(k[12], k[13]); CE(k[14], k[15]); CE(k[12], k[14]); CE(k[13], k[15]); CE(k[13], k[14]); CE(k[8], k[12]); CE(k[10], k[14]); CE(k[10], k[12]); CE(k[9], k[13]); CE(k[11], k[15]); CE(k[11], k[13]); CE(k[9], k[10]); CE(k[11], k[12]); CE(k[13], k[14]); CE(k[0], k[8]); CE(k[4], k[12]); CE(k[4], k[8]); CE(k[2], k[10]); CE(k[6], k[14]); CE(k[6], k[10]); CE(k[2], k[4]); CE(k[6], k[8]); CE(k[10], k[12]); CE(k[1], k[9]); CE(k[5], k[13]); CE(k[5], k[9]); CE(k[3], k[11]); CE(k[7], k[15]); CE(k[7], k[11]); CE(k[3], k[5]); CE(k[7], k[9]); CE(k[11], k[13]); CE(k[1], k[2]); CE(k[3], k[4]); CE(k[5], k[6]); CE(k[7], k[8]); CE(k[9], k[10]); CE(k[11], k[12]); CE(k[13], k[14]); }
__device__ __forceinline__ void bitonic_merge16_desc(unsigned (&k)[16]) {
#pragma unroll
  for (int s = 8; s >= 1; s >>= 1)
#pragma unroll
    for (int i = 0; i < 16; ++i) if ((i & s) == 0) CE(k[i], k[i + s]);
}
__device__ __forceinline__ void merge_top16(unsigned (&a)[16], const unsigned (&b)[16]) {
#pragma unroll
  for (int i = 0; i < 16; ++i) a[i] = a[i] > b[15 - i] ? a[i] : b[15 - i];
  bitonic_merge16_desc(a);
}
__device__ __forceinline__ void xchg16(unsigned (&dst)[16], const unsigned (&src)[16], int mask) {
#pragma unroll
  for (int i = 0; i < 16; ++i) dst[i] = (unsigned)__shfl_xor((int)src[i], mask);
}
__device__ __forceinline__ void phase_peer_topk(const P& p, int bid, int nb) {
  const int tid_ = pg8::opaque_tid(), lane = tid_ & 63, wid = tid_ >> 6, part = lane & 3, r = lane & 7;
  const float* sc = (const float*)(p.ws + R_SC); int* eidx = (int*)(p.ws + R_EIDX); float* gate = (float*)(p.ws + R_GATE);
  for (int t = bid * 8 + wid; t < T; t += nb * 8) {
    const float* src = sc + (size_t)t * 2048 + (lane >> 2) * 128 + part * 4;
    unsigned a[16], b[16];
#pragma unroll
    for (int i = 0; i < 4; ++i) { const f32x4 v = *(const f32x4*)(src + 16 * i); const int e0 = 127 - 16 * i - 4 * part;
      a[4 * i] = (f2ord(v.x) & ~127u) | (unsigned)e0; a[4 * i + 1] = (f2ord(v.y) & ~127u) | (unsigned)(e0 - 1); a[4 * i + 2] = (f2ord(v.z) & ~127u) | (unsigned)(e0 - 2); a[4 * i + 3] = (f2ord(v.w) & ~127u) | (unsigned)(e0 - 3); }
#pragma unroll
    for (int i = 0; i < 4; ++i) { const f32x4 v = *(const f32x4*)(src + 64 + 16 * i); const int e0 = 127 - 64 - 16 * i - 4 * part;
      b[4 * i] = (f2ord(v.x) & ~127u) | (unsigned)e0; b[4 * i + 1] = (f2ord(v.y) & ~127u) | (unsigned)(e0 - 1); b[4 * i + 2] = (f2ord(v.z) & ~127u) | (unsigned)(e0 - 2); b[4 * i + 3] = (f2ord(v.w) & ~127u) | (unsigned)(e0 - 3); }
    sort16_desc(a); sort16_desc(b); merge_top16(a, b);
    xchg16(b, a, 1); merge_top16(a, b);
    xchg16(b, a, 2); merge_top16(a, b);
    xchg16(b, a, 4);
    const bool second = (lane & 4) != 0;
    unsigned k1[16], k2[16];
#pragma unroll
    for (int i = 0; i < 16; ++i) { k1[i] = second ? b[i] : a[i]; k2[i] = second ? a[i] : b[i]; }
    float v2[16];
#pragma unroll
    for (int i = 0; i < 16; ++i) v2[i] = ord2f(k2[i] & ~127u);
    unsigned k1r = k1[0], k1x = k1[8];
#pragma unroll
    for (int j = 1; j < 8; ++j) { k1r = (r == j) ? k1[j] : k1r; k1x = (r == j) ? k1[8 + j] : k1x; }
    const float v1r = ord2f(k1r & ~127u), v1x = ord2f(k1x & ~127u), vmax = ord2f(k1[0] & ~127u) + v2[0];
    unsigned ck[16]; float cs_[16];
#pragma unroll
    for (int bb = 0; bb < 16; ++bb) { cs_[bb] = v1r + v2[bb]; const bool valid = (r + 1) * (bb + 1) <= 16;
      ck[bb] = valid ? ((f2ord(cs_[bb]) & ~255u) | (unsigned)(255 - (r * 16 + bb))) : 0u; }
    const float sx = v1x + v2[0]; const unsigned xk = (f2ord(sx) & ~255u) | (unsigned)(255 - ((8 + r) * 16));
    unsigned m[16];
#pragma unroll
    for (int i = 0; i < 16; ++i) m[i] = ck[i];
    xchg16(b, m, 1); merge_top16(m, b); xchg16(b, m, 2); merge_top16(m, b); xchg16(b, m, 4); merge_top16(m, b);
#pragma unroll
    for (int j = 0; j < 8; ++j) b[j] = (unsigned)__shfl((int)xk, (lane & ~7) + j);
#pragma unroll
    for (int j = 8; j < 16; ++j) b[j] = 0u;
    merge_top16(m, b);
    const unsigned t16 = m[15];
    int cnt = 0; float es = 0.f; float ev[16];
#pragma unroll
    for (int bb = 0; bb < 16; ++bb) { const bool sel = ck[bb] >= t16 && ck[bb] != 0u; ev[bb] = sel ? fast_exp(cs_[bb] - vmax) : 0.f; es += ev[bb]; cnt += sel ? 1 : 0; }
    const bool selx = xk >= t16; const float evx = selx ? fast_exp(sx - vmax) : 0.f; es += evx;
    const int tot = cnt + (selx ? 1 : 0);
    int off = 0;
#pragma unroll
    for (int j = 0; j < 8; ++j) { const int tj = __shfl(tot, (lane & ~7) + j); off += (j < r) ? tj : 0; }
    es += __shfl_xor(es, 1); es += __shfl_xor(es, 2); es += __shfl_xor(es, 4);
    const float inv = 1.0f / es;
    const size_t obase = (size_t)t * 128 + (lane >> 3) * 16 + off;
    const int i1r = 127 - (int)(k1r & 127u), i1x = 127 - (int)(k1x & 127u);
#pragma unroll
    for (int bb = 0; bb < 16; ++bb) if (bb < cnt) { eidx[obase + bb] = i1r * 128 + (127 - (int)(k2[bb] & 127u)); gate[obase + bb] = ev[bb] * inv; }
    if (selx) { eidx[obase + cnt] = i1x * 128 + (127 - (int)(k2[0] & 127u)); gate[obase + cnt] = evx * inv; }
  }
}
struct EpiAttn {
  static constexpr bool PERM = true, AFTER_DRAIN = false;
  unsigned char* ws; const float* cs;
  __device__ __forceinline__ void operator()(const f32x4 (&acc)[2][2][4][2], const Unit& u, int wr, int wc, int fr, int fq) const {
    const int row0 = u.pm * 256 + wr * 64 + fr;
    if (u.pn < 5) {
      const bool isq = u.pn < 4; const float scale = isq ? 0.125f : 1.0f; const int ld = isq ? 1024 : 256;
      bf16_t* dst = (bf16_t*)(ws + (isq ? R_Q : R_KB)) + (isq ? u.pn * 256 : 0) + wc * 32 + 8 * fq;
      const bool ropewave = (wc & 1) == 0;
#pragma unroll
      for (int ai = 0; ai < 2; ++ai)
#pragma unroll
        for (int m = 0; m < 4; ++m) { const int row = row0 + ai * 128 + m * 16;
          f32x4 c4[4];
          if (ropewave) {
#pragma unroll
            for (int i = 0; i < 4; ++i) c4[i] = *(const f32x4*)(cs + (size_t)row * 16 + i * 4); }
#pragma unroll
          for (int bj = 0; bj < 2; ++bj) { f32x4 v0 = acc[ai][bj][m][0], v1 = acc[ai][bj][m][1];
            if (ropewave) {
              f32x4 p0, p1;
#pragma unroll
              for (int j = 0; j < 4; ++j) { p0[j] = __shfl_xor(v0[j], 16); p1[j] = __shfl_xor(v1[j], 16); }
              const float sg = (fq == 0) ? -1.0f : 1.0f;
              if (fq < 2) {
                v0[0] = v0[0] * c4[0].x + sg * p0[0] * c4[0].y; v0[1] = v0[1] * c4[0].z + sg * p0[1] * c4[0].w; v0[2] = v0[2] * c4[1].x + sg * p0[2] * c4[1].y; v0[3] = v0[3] * c4[1].z + sg * p0[3] * c4[1].w;
                v1[0] = v1[0] * c4[2].x + sg * p1[0] * c4[2].y; v1[1] = v1[1] * c4[2].z + sg * p1[1] * c4[2].w; v1[2] = v1[2] * c4[3].x + sg * p1[2] * c4[3].y; v1[3] = v1[3] * c4[3].z + sg * p1[3] * c4[3].w;
              }
            }
            v0 = v0 * scale; v1 = v1 * scale;
            u32x4 w; w.x = cvt_pk_bf16(v0[0], v0[1]); w.y = cvt_pk_bf16(v0[2], v0[3]); w.z = cvt_pk_bf16(v1[0], v1[1]); w.w = cvt_pk_bf16(v1[2], v1[3]);
            *(u32x4*)(dst + (size_t)row * ld + bj * 128) = w; } }
    } else {
      bf16_t* vT = (bf16_t*)(ws + R_VT);
#pragma unroll
      for (int ai = 0; ai < 2; ++ai)
#pragma unroll
        for (int m = 0; m < 4; ++m) { const int row = row0 + ai * 128 + m * 16, b = row >> 12, s = row & 4095;
#pragma unroll
          for (int bj = 0; bj < 2; ++bj)
#pragma unroll
            for (int n = 0; n < 2; ++n) { const int col = bj * 128 + wc * 32 + 8 * fq + 4 * n;
              bf16_t* d0 = vT + ((size_t)(b * 4 + (col >> 6)) * 64 + (col & 63)) * 4096 + s;
              const unsigned w0 = cvt_pk_bf16(acc[ai][bj][m][n][0], acc[ai][bj][m][n][1]), w1 = cvt_pk_bf16(acc[ai][bj][m][n][2], acc[ai][bj][m][n][3]);
              d0[0] = (bf16_t)(w0 & 0xffffu); d0[4096] = (bf16_t)(w0 >> 16); d0[2 * 4096] = (bf16_t)(w1 & 0xffffu); d0[3 * 4096] = (bf16_t)(w1 >> 16); } }
    }
  }
};
__device__ __forceinline__ void phase_gemm_qkv(const P& p, LAS unsigned char* lds, int bid, int nb) {
  EpiAttn E; E.ws = p.ws; E.cs = (const float*)(p.ws + WS_CS);
  run_gemm(lds, (const bf16_t*)(p.ws + WS_HB16), (const bf16_t*)(p.ws + WS_WT_QKV), T, 1536, 1024, E, bid, nb);
}
__device__ __forceinline__ void phase_attn(const P& p, int bid, int nb) {
  const int tid_ = pg8::opaque_tid(), lane = tid_ & 63, wid = tid_ >> 6, l31 = lane & 31, hh = lane >> 5;
  const bf16_t* q = (const bf16_t*)(p.ws + R_Q); const bf16_t* kb = (const bf16_t*)(p.ws + R_KB); const bf16_t* vT = (const bf16_t*)(p.ws + R_VT); bf16_t* ao = (bf16_t*)(p.ws + R_AO);
  for (int wt = bid * 8 + wid; wt < 8192; wt += nb * 8) {
    const int qb = wt & 127, hq = (wt >> 7) & 15, b = wt >> 11, kvh = hq >> 2, i0 = qb * 32, k0 = i0 - 128;
    const float sink = p.sw_sinks[hq];
    bf16x8 bq[4];
#pragma unroll
    for (int ks = 0; ks < 4; ++ks) bq[ks] = *(const bf16x8*)(q + (size_t)(b * SEQ + i0 + l31) * 1024 + hq * 64 + ks * 16 + hh * 8);
    f32x16 s[5];
#pragma unroll
    for (int kt = 0; kt < 5; ++kt) {
      for (int i = 0; i < 16; ++i) s[kt][i] = 0.f;
      const int kb0 = k0 + kt * 32;
      if (kb0 >= 0) {
        const bf16_t* kp = kb + (size_t)(b * SEQ + kb0 + l31) * 256 + kvh * 64 + hh * 8;
#pragma unroll
        for (int ks = 0; ks < 4; ++ks) { const bf16x8 a = *(const bf16x8*)(kp + ks * 16); s[kt] = MFMA32(a, bq[ks], s[kt]); }
      }
    }
    const int qp = i0 + l31; float m = sink;
#pragma unroll
    for (int kt = 0; kt < 5; ++kt)
#pragma unroll
      for (int r = 0; r < 16; ++r) { const int kp = k0 + kt * 32 + (r & 3) + 8 * (r >> 2) + 4 * hh; const bool valid = (kp >= 0) && (kp <= qp) && (kp > qp - 128);
        s[kt][r] = valid ? s[kt][r] : -INFINITY; m = fmaxf(m, s[kt][r]); }
    m = fmaxf(m, __shfl_xor(m, 32));
    float lsum = 0.f;
#pragma unroll
    for (int kt = 0; kt < 5; ++kt)
#pragma unroll
      for (int r = 0; r < 16; ++r) { const float e = fast_exp(s[kt][r] - m); s[kt][r] = e; lsum += e; }
    lsum += __shfl_xor(lsum, 32); lsum += fast_exp(sink - m);
    f32x16 o[2];
    for (int i = 0; i < 16; ++i) { o[0][i] = 0.f; o[1][i] = 0.f; }
#pragma unroll
    for (int kt = 0; kt < 5; ++kt) {
      const int kb0 = k0 + kt * 32;
      if (kb0 >= 0) {
#pragma unroll
        for (int st = 0; st < 2; ++st) {
          u32x4 pk; pk.x = cvt_pk_bf16(s[kt][8 * st], s[kt][8 * st + 1]); pk.y = cvt_pk_bf16(s[kt][8 * st + 2], s[kt][8 * st + 3]);
          pk.z = cvt_pk_bf16(s[kt][8 * st + 4], s[kt][8 * st + 5]); pk.w = cvt_pk_bf16(s[kt][8 * st + 6], s[kt][8 * st + 7]);
          const bf16x8 pb = __builtin_bit_cast(bf16x8, pk);
#pragma unroll
          for (int et = 0; et < 2; ++et) { const bf16_t* vp = vT + ((size_t)(b * 4 + kvh) * 64 + et * 32 + l31) * 4096 + kb0 + 16 * st + 4 * hh;
            const u32x2 lo = *(const u32x2*)vp, hi = *(const u32x2*)(vp + 8);
            const bf16x8 a = __builtin_bit_cast(bf16x8, (u32x4){lo.x, lo.y, hi.x, hi.y});
            o[et] = MFMA32(a, pb, o[et]); }
        }
      }
    }
    const float inv = 1.0f / lsum;
#pragma unroll
    for (int et = 0; et < 2; ++et)
#pragma unroll
      for (int g = 0; g < 4; ++g)
        *(u32x2*)(ao + (size_t)(b * SEQ + i0 + l31) * 1024 + hq * 64 + et * 32 + 8 * g + 4 * hh) =
            (u32x2){cvt_pk_bf16(o[et][4 * g] * inv, o[et][4 * g + 1] * inv), cvt_pk_bf16(o[et][4 * g + 2] * inv, o[et][4 * g + 3] * inv)};
  }
}
__device__ __forceinline__ void phase_gemm_swo(const P& p, LAS unsigned char* lds, int bid, int nb) {
  EpiResid E; E.res = p.out; E.z = (float*)(p.ws + R_Z);
  run_gemm(lds, (const bf16_t*)(p.ws + R_AO), (const bf16_t*)(p.ws + WS_WT_SWO), T, 1024, 1024, E, bid, nb);
}
#ifndef R_PREP
#define R_PREP 1
#endif
#ifndef R_G1
#define R_G1 1
#endif
#ifndef R_HA
#define R_HA 1
#endif
#ifndef R_HB
#define R_HB 1
#endif
#ifndef R_HC
#define R_HC 1
#endif
#ifndef R_G2
#define R_G2 1
#endif
#ifndef R_LN
#define R_LN 1
#endif
#ifndef R_SC_
#define R_SC_ 1
#endif
#ifndef R_TK
#define R_TK 1
#endif
#ifndef R_GA
#define R_GA 1
#endif
#ifndef R_QKV
#define R_QKV 1
#endif
#ifndef R_AT
#define R_AT 1
#endif
#ifndef R_SWO
#define R_SWO 1
#endif
__global__ __launch_bounds__(512, 2) void mega_fwd(P p) {
  extern __shared__ __attribute__((aligned(16))) unsigned char shm[];
  LAS unsigned char* lds = (LAS unsigned char*)shm;
  cooperative_groups::grid_group grid = cooperative_groups::this_grid();
  const int bid = blockIdx.x, nb = gridDim.x;
  volatile LAS unsigned* xst = (volatile LAS unsigned*)(lds + 131072);
  if (threadIdx.x < 4) xst[threadIdx.x] = 0u;
  __syncthreads();
  const XcdBarrier xb = xcd_barrier_post((unsigned*)(p.ws + WS_CTL), xst);
  float* hA = (float*)(p.ws + WS_HA); bf16_t* hb = (bf16_t*)(p.ws + WS_HB16); const float* z = (const float*)(p.ws + R_Z);
  _Pragma("nounroll") for (int r_ = 0; r_ < R_PREP; ++r_) { phase_prep(p, lds, bid, nb); grid.sync(); }
  _Pragma("nounroll") for (int r_ = 0; r_ < R_G1; ++r_) { phase_gemm1(p, lds, bid, nb); xcd_barrier(xb); }
  _Pragma("nounroll") for (int r_ = 0; r_ < R_HA; ++r_) { phase_hgrn_a(p, lds, bid, nb); xcd_barrier(xb); }
  _Pragma("nounroll") for (int r_ = 0; r_ < R_HB; ++r_) { phase_hgrn_b(p, bid, nb); xcd_barrier(xb); }
  _Pragma("nounroll") for (int r_ = 0; r_ < R_HC; ++r_) { phase_hgrn_c(p, bid, nb); xcd_barrier(xb); }
  _Pragma("nounroll") for (int r_ = 0; r_ < R_G2; ++r_) { phase_gemm2(p, lds, bid, nb); xcd_barrier(xb); }
  _Pragma("nounroll") for (int r_ = 0; r_ < R_LN; ++r_) { phase_ln(z, p.ln_mix_g, p.ln_mix_b, hA, hb, bid, nb); xcd_barrier(xb); }
  _Pragma("nounroll") for (int r_ = 0; r_ < R_SC_; ++r_) { phase_peer_scores(p, 0, lds, bid, nb); xcd_barrier(xb); }
  _Pragma("nounroll") for (int r_ = 0; r_ < R_TK; ++r_) { phase_peer_topk(p, bid, nb); xcd_barrier(xb); }
  _Pragma("nounroll") for (int r_ = 0; r_ < R_GA; ++r_) { phase_peer_gather<16>(p, 0, hA, p.out, bid, nb); xcd_barrier(xb); }
  _Pragma("nounroll") for (int r_ = 0; r_ < R_QKV; ++r_) { phase_gemm_qkv(p, lds, bid, nb); xcd_barrier(xb); }
  _Pragma("nounroll") for (int r_ = 0; r_ < R_AT; ++r_) { phase_attn(p, bid, nb); xcd_barrier(xb); }
  _Pragma("nounroll") for (int r_ = 0; r_ < R_SWO; ++r_) { phase_gemm_swo(p, lds, bid, nb); xcd_barrier(xb); }
  _Pragma("nounroll") for (int r_ = 0; r_ < R_LN; ++r_) { phase_ln(z, p.ln_mix_g + 1024, p.ln_mix_b + 1024, hA, hb, bid, nb); xcd_barrier(xb); }
  _Pragma("nounroll") for (int r_ = 0; r_ < R_SC_; ++r_) { phase_peer_scores(p, 1, lds, bid, nb); xcd_barrier(xb); }
  _Pragma("nounroll") for (int r_ = 0; r_ < R_TK; ++r_) { phase_peer_topk(p, bid, nb); xcd_barrier(xb); }
  _Pragma("nounroll") for (int r_ = 0; r_ < R_GA; ++r_) { phase_peer_gather<16>(p, 1, hA, p.out, bid, nb); if (r_ + 1 < R_GA) xcd_barrier(xb); }
}
}

extern "C" void kernel_launch(void* const* d_in, const int* in_sizes, int n_in, void* d_out, int out_size, void* d_ws, size_t ws_size, hipStream_t stream) {
  constexpr int LDSB = 131072 + 16;
  static int grid_blocks = 0;
  if (!grid_blocks) {
    int dev = 0, cus = 0, per_cu = 0;
    hipGetDevice(&dev);
    hipDeviceGetAttribute(&cus, hipDeviceAttributeMultiprocessorCount, dev);
    hipFuncSetAttribute((const void*)mk::mega_fwd, hipFuncAttributeMaxDynamicSharedMemorySize, LDSB);
    hipOccupancyMaxActiveBlocksPerMultiprocessor(&per_cu, (const void*)mk::mega_fwd, 512, LDSB);
    if (per_cu < 1) per_cu = 1;
    if (per_cu > 1) per_cu = 1;
    grid_blocks = cus * per_cu;
  }
  mk::P p{};
  p.x = (const float*)d_in[0]; p.pos = (const int*)d_in[1]; p.hg_w_in = (const float*)d_in[2]; p.hg_lb = (const float*)d_in[3]; p.hg_norm_w = (const float*)d_in[4];
  p.hg_w_o = (const float*)d_in[5]; p.sw_w_q = (const float*)d_in[6]; p.sw_sinks = (const float*)d_in[7]; p.sw_w_o = (const float*)d_in[8]; p.w_kv = (const float*)d_in[9];
  p.peer_w_q = (const float*)d_in[10]; p.peer_sk = (const float*)d_in[11]; p.peer_u = (const float*)d_in[12]; p.peer_v = (const float*)d_in[13];
  p.ln_mix_g = (const float*)d_in[14]; p.ln_mix_b = (const float*)d_in[15]; p.ln_ffn_g = (const float*)d_in[16]; p.ln_ffn_b = (const float*)d_in[17];
  p.out = (float*)d_out; p.ws = (unsigned char*)d_ws;
  hipMemsetAsync(d_ws, 0, XCD_BAR_WORDS * 4, stream);
  void* args[] = {&p};
  hipError_t e = hipLaunchCooperativeKernel((const void*)mk::mega_fwd, dim3(grid_blocks), dim3(512), args, LDSB, stream);
  if (e != hipSuccess) fprintf(stderr, "cooperative launch failed: %s (grid %d)\n", hipGetErrorString(e), grid_blocks);
}
```

```cpp
#include <hip/hip_runtime.h>
#include <hip/hip_cooperative_groups.h>
#include <math.h>
#include <cstdio>
namespace pg8 {
__device__ __forceinline__ int opaque_tid() { int t = (int)threadIdx.x; asm volatile("" : "+v"(t)); return t; }
#define PG8_LAS __attribute__((address_space(3)))
typedef unsigned short bf16_t;
typedef short bf16x8 __attribute__((ext_vector_type(8)));
typedef float f32x4 __attribute__((ext_vector_type(4)));
typedef unsigned u32x4 __attribute__((ext_vector_type(4)));
constexpr int BM = 256, BK = 64, HALF = 128, HTB = HALF * BK * 2  , STAGE_BYTES = 8 * HTB, NXCD = 8, WGM = 8;

__host__ __device__ __forceinline__ int lds_byte(int r, int c) { const int st = (r >> 4) * 2 + (c >> 5), rr = r & 15, cc = c & 31, ob = rr * 64 + cc * 2; return st * 1024 + (ob ^ (((ob >> 9) & 1) << 5)); }
__host__ __device__ __forceinline__ void stage_rc(int b, int& R, int& C) { const int st = b / 1024, sb = b % 1024, swz = sb ^ (((sb >> 9) & 1) << 5); R = (st >> 1) * 16 + swz / 64; C = (st & 1) * 32 + (swz % 64) / 2; }
__host__ __device__ __forceinline__ int perm32(int rho) { const int n = rho >> 4, i = rho & 15; return 8 * (i >> 2) + 4 * n + (i & 3); }

struct Unit { int pm, pn; };
struct Gemm { const bf16_t* A; const bf16_t* Bt; int M, N, K; };

struct StaticOrder {
    int nM, nN, nwg, G, c;
    __host__ __device__ void init(int M, int N, int G_, int c_) { nM = M / BM; nN = N / BM; nwg = nM * nN; G = G_; c = c_; }
    __host__ __device__ bool next(int i, Unit& u) const {
        const long L = (long)i * G + c; if (L >= nwg) return false;
        int wgid = (int)L; { const int q = nwg / NXCD, r = nwg % NXCD, xcd = wgid % NXCD, off = wgid / NXCD; wgid = (xcd < r ? xcd * (q + 1) : r * (q + 1) + (xcd - r) * q) + off; }
        const int nig = WGM * nN, gid = wgid / nig, fm = gid * WGM, gsz = (nM - fm) < WGM ? (nM - fm) : WGM;
        u.pm = fm + ((wgid % nig) % gsz); u.pn = (wgid % nig) / gsz; return true;
    }
    __device__ __forceinline__ void a_ready(const Unit&) const {}
    __device__ __forceinline__ void done(const Unit&) const {}
};
typedef __bf16 bf16v2_t __attribute__((ext_vector_type(2)));
typedef float f32v2_t __attribute__((ext_vector_type(2)));
__device__ __forceinline__ unsigned cvt_pk_bf16(float lo, float hi) { const f32v2_t v = {lo, hi}; return __builtin_bit_cast(unsigned, __builtin_convertvector(v, bf16v2_t)); }
typedef float f32x2 __attribute__((ext_vector_type(2)));

template <class Epi, class Sched, bool STAMP = false>
__device__ __forceinline__ void gemm_phase(PG8_LAS unsigned char* lds, const Gemm g, const Sched& S, const Epi& E, unsigned long long* stamps) {
    const int tid = opaque_tid(), wid = __builtin_amdgcn_readfirstlane(tid >> 6), lane = tid & 63, wr = wid >> 2, wc = wid & 3, fr = lane & 15, fq = lane >> 4;
    const int K = g.K, nt = K / BK;
    int ts_lo = 0, ts_hi = 0, nts = 0; const unsigned long long rt_entry = STAMP ? (unsigned long long)wall_clock64() : 0ull;
#define PG8_STAMP() do { if (STAMP && wid == 0 && nts < 64) { const unsigned long long _c = (unsigned long long)clock64(); \
        ts_lo = (lane == nts) ? (int)(unsigned)_c : ts_lo; ts_hi = (lane == nts) ? (int)(unsigned)(_c >> 32) : ts_hi; ++nts; } } while (0)
    PG8_STAMP();
    unsigned voffA[2], voffB[2];
#pragma unroll
    for (int i = 0; i < 2; ++i) { int R, C; stage_rc(tid * 16 + i * 8192, R, C); const int Rb = Epi::PERM ? ((R & ~31) + perm32(R & 31)) : R;
        voffA[i] = (unsigned)(R * K + C) * 2u; voffB[i] = (unsigned)(Rb * K + C) * 2u; }
    const size_t kstep = (size_t)(BK * 2);
    const size_t hstep = (size_t)HALF * K * 2;
    const size_t tstep = 2 * hstep;
    const unsigned ldsw = (unsigned)wid * 1024u;
    const int aoff = lds_byte(wr * 64 + fr, fq * 8), boff = lds_byte(wc * 32 + fr, fq * 8);
#define PG8_SA(b, h) (((b) * 2 + (h)) * HTB)
#define PG8_SB(b, h) ((4 + (b) * 2 + (h)) * HTB)
#define PG8_STAGE(bufoff, gbase, voff) do { _Pragma("unroll") for (int _i = 0; _i < 2; ++_i) \
        __builtin_amdgcn_global_load_lds((const unsigned*)((const char*)(gbase) + (voff)[_i]), (PG8_LAS unsigned*)(lds + (bufoff) + ldsw + _i * 8192), 16, 0, 0); } while (0)
#define PG8_LDA(dst, b, h) do { _Pragma("unroll") for (int m = 0; m < 4; ++m) _Pragma("unroll") for (int k = 0; k < 2; ++k) dst[m][k] = *(const PG8_LAS bf16x8*)(lds + PG8_SA(b, h) + aoff + m * 2048 + k * 1024); } while (0)
#define PG8_LDB(dst, b, h) do { _Pragma("unroll") for (int n = 0; n < 2; ++n) _Pragma("unroll") for (int k = 0; k < 2; ++k) dst[n][k] = *(const PG8_LAS bf16x8*)(lds + PG8_SB(b, h) + boff + n * 2048 + k * 1024); } while (0)
#define PG8_MMA(ai, bj, At, Bt) do { __builtin_amdgcn_s_setprio(1); _Pragma("unroll") for (int m = 0; m < 4; ++m) _Pragma("unroll") for (int n = 0; n < 2; ++n) _Pragma("unroll") for (int k = 0; k < 2; ++k) \
        acc[ai][bj][m][n] = __builtin_amdgcn_mfma_f32_16x16x32_bf16(Bt[n][k], At[m][k], acc[ai][bj][m][n], 0, 0, 0); __builtin_amdgcn_s_setprio(0); } while (0)
#define PG8_WAIT_V(n) asm volatile("s_waitcnt vmcnt(" #n ")" ::: "memory")
#define PG8_WAIT_L(n) asm volatile("s_waitcnt lgkmcnt(" #n ")" ::: "memory")
#define PG8_BAR __builtin_amdgcn_s_barrier()
#define PG8_SCHED __builtin_amdgcn_sched_barrier(0)
    Unit cur, nxt; int ui = 0;
    if (!S.next(0, cur)) return;
    f32x4 acc[2][2][4][2];
#pragma unroll
    for (int a = 0; a < 2; ++a)
#pragma unroll
        for (int b = 0; b < 2; ++b)
#pragma unroll
            for (int m = 0; m < 4; ++m)
#pragma unroll
                for (int n = 0; n < 2; ++n) acc[a][b][m][n] = (f32x4){0.f, 0.f, 0.f, 0.f};
    bf16x8 At[4][2], B0[2][2], B1[2][2];
    const char* cA = (const char*)g.A + (size_t)cur.pm * tstep; const char* cB = (const char*)g.Bt + (size_t)cur.pn * tstep;
    S.a_ready(cur);
    PG8_STAGE(PG8_SB(0, 0), cB, voffB); PG8_STAGE(PG8_SA(0, 0), cA, voffA); PG8_STAGE(PG8_SB(0, 1), cB + hstep, voffB); PG8_STAGE(PG8_SA(0, 1), cA + hstep, voffA);
    if (wr == 1) PG8_BAR;
    PG8_WAIT_V(4); PG8_BAR;
    PG8_STAGE(PG8_SB(1, 0), cB + kstep, voffB); PG8_STAGE(PG8_SA(1, 0), cA + kstep, voffA); PG8_STAGE(PG8_SB(1, 1), cB + hstep + kstep, voffB);
    PG8_WAIT_V(6); PG8_BAR;
    PG8_STAMP();
    for (;;) {
        const bool has_next = S.next(ui + 1, nxt);
        const char* nA = has_next ? (const char*)g.A + (size_t)nxt.pm * tstep : cA; const char* nB = has_next ? (const char*)g.Bt + (size_t)nxt.pn * tstep : cB;
        for (int t = 0; t < nt; t += 2) {
            const bool last = (t == nt - 2);
            const char* a1 = cA + (size_t)(t + 1) * kstep;
            const char* a2 = last ? nA : cA + (size_t)(t + 2) * kstep; const char* b2 = last ? nB : cB + (size_t)(t + 2) * kstep;
            const char* a3 = a2 + kstep; const char* b3 = b2 + kstep;
            if (last && has_next) S.a_ready(nxt);
            PG8_LDB(B0, 0, 0); PG8_SCHED; PG8_LDA(At, 0, 0); PG8_STAGE(PG8_SA(1, 1), a1 + hstep, voffA);
            PG8_WAIT_L(8); PG8_BAR; PG8_WAIT_L(0); PG8_MMA(0, 0, At, B0); PG8_BAR; PG8_SCHED;
            PG8_LDB(B1, 0, 1); PG8_STAGE(PG8_SB(0, 0), b2, voffB);
            PG8_BAR; PG8_WAIT_L(0); PG8_MMA(0, 1, At, B1); PG8_BAR;
            PG8_LDA(At, 0, 1); PG8_STAGE(PG8_SA(0, 0), a2, voffA);
            PG8_BAR; PG8_WAIT_L(0); PG8_MMA(1, 0, At, B0); PG8_BAR; PG8_SCHED;
            PG8_STAGE(PG8_SB(0, 1), b2 + hstep, voffB);
            PG8_WAIT_V(6); PG8_BAR; PG8_MMA(1, 1, At, B1); PG8_BAR;
            PG8_LDB(B0, 1, 0); PG8_SCHED; PG8_LDA(At, 1, 0); PG8_STAGE(PG8_SA(0, 1), a2 + hstep, voffA);
            PG8_WAIT_L(8); PG8_BAR; PG8_WAIT_L(0); PG8_MMA(0, 0, At, B0); PG8_BAR; PG8_SCHED;
            PG8_LDB(B1, 1, 1); PG8_STAGE(PG8_SB(1, 0), b3, voffB);
            PG8_BAR; PG8_WAIT_L(0); PG8_MMA(0, 1, At, B1); PG8_BAR;
            PG8_LDA(At, 1, 1); PG8_STAGE(PG8_SA(1, 0), a3, voffA);
            PG8_BAR; PG8_WAIT_L(0); PG8_MMA(1, 0, At, B0); PG8_BAR; PG8_SCHED;
            PG8_STAGE(PG8_SB(1, 1), b3 + hstep, voffB);
            PG8_WAIT_V(6); PG8_BAR; PG8_MMA(1, 1, At, B1); PG8_BAR;
        }
        PG8_STAMP();
        if constexpr (!Epi::AFTER_DRAIN) { E(acc, cur, wr, wc, fr, fq); S.done(cur); }
        PG8_STAMP();
        if (!has_next) break;
#pragma unroll
        for (int a = 0; a < 2; ++a)
#pragma unroll
            for (int b = 0; b < 2; ++b)
#pragma unroll
                for (int m = 0; m < 4; ++m)
#pragma unroll
                    for (int n = 0; n < 2; ++n) acc[a][b][m][n] = (f32x4){0.f, 0.f, 0.f, 0.f};
        cur = nxt; cA = nA; cB = nB; ++ui;
    }
    PG8_WAIT_V(0);
    if (wr == 0) PG8_BAR;
    PG8_BAR;
    if constexpr (Epi::AFTER_DRAIN) { E.fused(acc, cur, wr, wc, fr, fq, lds, wid, lane); S.done(cur); }
    PG8_STAMP();
    if (STAMP && wid == 0) { stamps[lane] = lane < nts ? (((unsigned long long)(unsigned)ts_hi << 32) | (unsigned)ts_lo) : 0ull;
        if (lane == 62) stamps[62] = rt_entry; if (lane == 63) stamps[63] = (unsigned long long)wall_clock64(); }
#undef PG8_STAMP
#undef PG8_SA
#undef PG8_SB
#undef PG8_STAGE
#undef PG8_LDA
#undef PG8_LDB
#undef PG8_MMA
#undef PG8_WAIT_V
#undef PG8_WAIT_L
#undef PG8_BAR
#undef PG8_SCHED
}
}
namespace mk {
using pg8::bf16_t; using pg8::f32x4; using pg8::u32x4; using pg8::bf16x8; using pg8::Unit; using pg8::cvt_pk_bf16;
#define LAS __attribute__((address_space(3)))
typedef unsigned u32x2 __attribute__((ext_vector_type(2)));
typedef float f32x16 __attribute__((ext_vector_type(16)));
constexpr int T = 16384, D = 1024, SEQ = 4096, NTHR = 512;
constexpr float ALPHA = 1.41421356237f;
constexpr size_t MB = (size_t)1 << 20;
constexpr size_t WS_CTL = 0, WS_LBV = 1 * MB, WS_CS = 2 * MB, WS_WT_IN = 4 * MB, WS_WT_O = 12 * MB, WS_WT_QKV = 14 * MB, WS_WT_SWO = 17 * MB, WS_WT_PEER = 19 * MB,
                 WS_SCL = 3 * MB, WS_TABU = 32 * MB, WS_TABV = 64 * MB, WS_HA = 160 * MB, WS_HB16 = 224 * MB, WS_R3 = 256 * MB;
constexpr size_t R_QS = WS_R3, R_LF = WS_R3 + 32 * MB, R_VI = WS_R3 + 96 * MB, R_GS = WS_R3 + 128 * MB, R_ST = WS_R3 + 160 * MB, R_DEC = WS_R3 + 224 * MB, R_Z = WS_R3 + 160 * MB;
constexpr size_t R_SC = WS_R3, R_EIDX = WS_R3 + 128 * MB, R_GATE = WS_R3 + 136 * MB;
constexpr size_t R_Q = WS_R3, R_KB = WS_R3 + 32 * MB, R_VT = WS_R3 + 40 * MB, R_AO = WS_R3 + 48 * MB;

struct P {
  const float* x; const int* pos; const float *hg_w_in, *hg_lb, *hg_norm_w, *hg_w_o, *sw_w_q, *sw_sinks, *sw_w_o, *w_kv, *peer_w_q, *peer_sk, *peer_u, *peer_v,
      *ln_mix_g, *ln_mix_b, *ln_ffn_g, *ln_ffn_b;
  float* out; unsigned char* ws;
};

__device__ __forceinline__ float bf2f(unsigned short b) { return __uint_as_float(((unsigned)b) << 16); }
__device__ __forceinline__ float bflo(unsigned w) { return __uint_as_float(w << 16); }
__device__ __forceinline__ float bfhi(unsigned w) { return __uint_as_float(w & 0xffff0000u); }
__device__ __forceinline__ float fast_exp(float x) { return __builtin_amdgcn_exp2f(x * 1.44269504089f); }
__device__ __forceinline__ float fast_rcp(float x) { return __builtin_amdgcn_rcpf(x); }
__device__ __forceinline__ float fast_sigmoid(float x) { return fast_rcp(1.0f + fast_exp(-x)); }
__device__ __forceinline__ float fast_silu(float x) { return x * fast_sigmoid(x); }
__device__ __forceinline__ float wave_sum(float v) {
#pragma unroll
  for (int o = 1; o < 64; o <<= 1) v += __shfl_xor(v, o);
  return v;
}
typedef float f32x2 __attribute__((ext_vector_type(2)));
__device__ __forceinline__ unsigned pk4_fp8(float a, float b, float c, float d) { int w = 0; w = __builtin_amdgcn_cvt_pk_fp8_f32(a, b, w, false); w = __builtin_amdgcn_cvt_pk_fp8_f32(c, d, w, true); return (unsigned)w; }
#define XB_TMO      128
#define XB_XCNT(j)  (256  + 64 * (j))
#define XB_XSUB(j)  (1280 + 64 * (j))
#define XB_XGEN(j)  (2304 + 64 * (j))
#define XB_TOP      3328
#define XB_TOPGEN   3392
#define XCD_BAR_WORDS 3456
#define XB_SPIN_CAP (1u << 18)


__device__ __forceinline__ unsigned xb_ld(unsigned* p)              { return __hip_atomic_load(p, __ATOMIC_RELAXED, __HIP_MEMORY_SCOPE_AGENT); }
__device__ __forceinline__ unsigned xb_add(unsigned* p, unsigned v) { return __hip_atomic_fetch_add(p, v, __ATOMIC_RELAXED, __HIP_MEMORY_SCOPE_AGENT); }
__device__ __forceinline__ unsigned xb_xcc_id() { return (unsigned)__builtin_amdgcn_s_getreg((3 << 11) | 20) & 0xFu; }
#define XB_SPIN(cond, bar) do { unsigned _sp = 0; while (cond) { __builtin_amdgcn_s_sleep(1); \
    if ((++_sp & 255u) == 0u) { if (xb_ld(&(bar)[XB_TMO])) break; if (_sp > XB_SPIN_CAP) { atomicAdd(&(bar)[XB_TMO], 1u); break; } } } } while (0)

struct XcdBarrier {
    unsigned* bar; unsigned x;
    volatile LAS unsigned* st;
};

__device__ __forceinline__ XcdBarrier xcd_barrier_post(unsigned* bar, volatile LAS unsigned* st) {
    XcdBarrier b; b.bar = bar; b.x = xb_xcc_id(); b.st = st;
    if (threadIdx.x == 0) (void)xb_add(&bar[XB_XCNT(b.x)], 1u);
    return b;
}
__device__ __forceinline__ void xcd_barrier_complete(unsigned* bar, unsigned x, unsigned& nloc, unsigned& nx) {
    const unsigned G = gridDim.x * gridDim.y * gridDim.z;
    unsigned sum, cnt, mine, sp = 0u;
    for (;;) {
        sum = 0u; cnt = 0u; mine = 0u;
#pragma unroll
        for (unsigned j = 0; j < 16; ++j) { const unsigned c = xb_ld(&bar[XB_XCNT(j)]); sum += c; cnt += (c > 0u) ? 1u : 0u; mine = (j == x) ? c : mine; }
        if (sum == G) break;
        __builtin_amdgcn_s_sleep(1);
        if ((++sp & 255u) == 0u) { if (xb_ld(&bar[XB_TMO])) break; if (sp > XB_SPIN_CAP) { atomicAdd(&bar[XB_TMO], 1u); break; } }
    }
    nloc = mine > 0u ? mine : 1u; nx = cnt > 0u ? cnt : 1u;
}

__device__ __forceinline__ void xcd_barrier(const XcdBarrier& b) {
    asm volatile("s_waitcnt vmcnt(0)" ::: "memory");
    __syncthreads();
    if (threadIdx.x == 0) {
        unsigned* bar = b.bar;
        __builtin_amdgcn_s_waitcnt(0);
        unsigned nloc = b.st[0], nx = b.st[1];
        if (nloc == 0u) { xcd_barrier_complete(bar, b.x, nloc, nx); b.st[0] = nloc; b.st[1] = nx; }
        const unsigned old = xb_add(&bar[XB_XSUB(b.x)], 1u);
        const unsigned gen = old / nloc;
        if (old + 1u == (gen + 1u) * nloc) {
            __builtin_amdgcn_fence(__ATOMIC_RELEASE, "agent");
            asm volatile("s_waitcnt vmcnt(0)" ::: "memory");
            const unsigned og = xb_add(&bar[XB_TOP], 1u);
            const unsigned tg = og / nx;
            if (og + 1u == (tg + 1u) * nx) xb_add(&bar[XB_TOPGEN], 1u);
            else XB_SPIN(xb_ld(&bar[XB_TOPGEN]) == tg, bar);
            __builtin_amdgcn_fence(__ATOMIC_ACQUIRE, "agent");
            xb_add(&bar[XB_XGEN(b.x)], 1u);
            asm volatile("s_waitcnt vmcnt(0)" ::: "memory");
        } else {
            XB_SPIN(xb_ld(&bar[XB_XGEN(b.x)]) == gen, bar);
            __builtin_amdgcn_fence(__ATOMIC_ACQUIRE, "agent");
            asm volatile("s_waitcnt vmcnt(0)" ::: "memory");
        }
    }
    __syncthreads();
}
__device__ __forceinline__ void cvt_stream(const float* __restrict__ src, bf16_t* __restrict__ dst, size_t n, size_t gtid, size_t gthreads) {
  const size_t n8 = n >> 3;
  for (size_t i = gtid; i < n8; i += gthreads) {
    const f32x4 a = ((const f32x4*)src)[2 * i], b = ((const f32x4*)src)[2 * i + 1];
    u32x4 o; o.x = cvt_pk_bf16(a.x, a.y); o.y = cvt_pk_bf16(a.z, a.w); o.z = cvt_pk_bf16(b.x, b.y); o.w = cvt_pk_bf16(b.z, b.w);
    ((u32x4*)dst)[i] = o;
  }
}
__device__ __forceinline__ void cvt_rows_fp8(const float* __restrict__ src, unsigned char* __restrict__ dst, float* __restrict__ scl, int nrows, int gw, int ngw, int lane) {
  for (int r = gw; r < nrows; r += ngw) {
    const float* s = src + (size_t)r * 1024 + lane * 16;
    f32x4 v[4]; float m = 0.f;
#pragma unroll
    for (int i = 0; i < 4; ++i) { v[i] = *(const f32x4*)(s + 4 * i); m = fmaxf(fmaxf(m, fmaxf(fabsf(v[i].x), fabsf(v[i].y))), fmaxf(fabsf(v[i].z), fabsf(v[i].w))); }
#pragma unroll
    for (int o = 1; o < 64; o <<= 1) m = fmaxf(m, __shfl_xor(m, o));
    const float sc = m > 0.f ? 440.0f / m : 1.0f;
    u32x4 o4;
    o4.x = pk4_fp8(v[0].x * sc, v[0].y * sc, v[0].z * sc, v[0].w * sc); o4.y = pk4_fp8(v[1].x * sc, v[1].y * sc, v[1].z * sc, v[1].w * sc);
    o4.z = pk4_fp8(v[2].x * sc, v[2].y * sc, v[2].z * sc, v[2].w * sc); o4.w = pk4_fp8(v[3].x * sc, v[3].y * sc, v[3].z * sc, v[3].w * sc);
    *(u32x4*)(dst + (size_t)r * 1024 + lane * 16) = o4;
    if (lane == 0) scl[r] = m > 0.f ? m * (1.0f / 440.0f) : 1.0f;
  }
}
__device__ __forceinline__ void transpose_tile(const float* __restrict__ W, int K, int N, bf16_t* __restrict__ Wt, int row_off, int tile, LAS float* scr, int tid) {
  const int ntn = N / 64, kb = tile / ntn, nbk = tile % ntn, k0 = kb * 64, n0 = nbk * 64;
  { const int k = tid >> 3, n8 = (tid & 7) * 8;
    const f32x4 a = *(const f32x4*)(W + (size_t)(k0 + k) * N + n0 + n8), b = *(const f32x4*)(W + (size_t)(k0 + k) * N + n0 + n8 + 4);
    LAS float* s = scr + k * 65 + n8; s[0] = a.x; s[1] = a.y; s[2] = a.z; s[3] = a.w; s[4] = b.x; s[5] = b.y; s[6] = b.z; s[7] = b.w; }
  __syncthreads();
  { const int n = tid >> 3, k8 = (tid & 7) * 8; const LAS float* s = scr + k8 * 65 + n;
    u32x4 o; o.x = cvt_pk_bf16(s[0], s[65]); o.y = cvt_pk_bf16(s[130], s[195]); o.z = cvt_pk_bf16(s[260], s[325]); o.w = cvt_pk_bf16(s[390], s[455]);
    *(u32x4*)(Wt + (size_t)(row_off + n0 + n) * K + k0 + k8) = o; }
  __syncthreads();
}
__device__ __forceinline__ void peer_fold_item(const P& p, int item, LAS float* lds, int tid) {
  const int kt = item & 15, hc = (item >> 4) & 15, l = item >> 8, k0 = kt * 64;
  LAS float* sks = lds;
  LAS float* wqs = lds + 128 * 132;
  const float* SK = p.peer_sk + ((size_t)l * 16 + hc) * 128 * 128;
  const float* WQ = p.peer_w_q + (size_t)l * 1024 * 2048 + hc * 128;
  { const int key = tid & 127, dq = tid >> 7;
#pragma unroll
    for (int j = 0; j < 8; ++j) { const int d4 = (dq + 4 * j) * 4; const f32x4 v = *(const f32x4*)(SK + key * 128 + d4);
      sks[(d4 + 0) * 132 + key] = v.x; sks[(d4 + 1) * 132 + key] = v.y; sks[(d4 + 2) * 132 + key] = v.z; sks[(d4 + 3) * 132 + key] = v.w; } }
  { const int k = tid & 63, dq = tid >> 6;
#pragma unroll
    for (int j = 0; j < 4; ++j) { const int d4 = (dq + 8 * j) * 4; const f32x4 v = *(const f32x4*)(WQ + (size_t)(k0 + k) * 2048 + d4);
      wqs[(d4 + 0) * 68 + k] = v.x; wqs[(d4 + 1) * 68 + k] = v.y; wqs[(d4 + 2) * 68 + k] = v.z; wqs[(d4 + 3) * 68 + k] = v.w; } }
  __syncthreads();
  const int kq = tid & 15, keyq = tid >> 4;
  float acc[4][4];
#pragma unroll
  for (int i = 0; i < 4; ++i)
#pragma unroll
    for (int j = 0; j < 4; ++j) acc[i][j] = 0.f;
#pragma unroll 4
  for (int d = 0; d < 128; ++d) {
    const f32x4 a = *(const LAS f32x4*)(sks + d * 132 + keyq * 4), b = *(const LAS f32x4*)(wqs + d * 68 + kq * 4);
    const float av[4] = {a.x, a.y, a.z, a.w}, bv[4] = {b.x, b.y, b.z, b.w};
#pragma unroll
    for (int i = 0; i < 4; ++i)
#pragma unroll
      for (int j = 0; j < 4; ++j) acc[i][j] += av[i] * bv[j];
  }
  bf16_t* Wt = (bf16_t*)(p.ws + WS_WT_PEER) + ((size_t)l * 2048 + hc * 128) * 1024;
#pragma unroll
  for (int i = 0; i < 4; ++i) { u32x2 o; o.x = cvt_pk_bf16(acc[i][0], acc[i][1]); o.y = cvt_pk_bf16(acc[i][2], acc[i][3]);
    *(u32x2*)(Wt + (size_t)(keyq * 4 + i) * 1024 + k0 + kq * 4) = o; }
  __syncthreads();
}
__device__ __forceinline__ void phase_prep(const P& p, LAS unsigned char* lds, int bid, int nb) {
  const int tid = pg8::opaque_tid(); const size_t gtid = (size_t)bid * NTHR + tid, gth = (size_t)nb * NTHR;
  if (gtid < 1024) { const float a0 = p.hg_lb[gtid], a1 = p.hg_lb[1024 + gtid], mx = fmaxf(a0, a1), e0 = expf(a0 - mx), e1 = expf(a1 - mx); ((float*)(p.ws + WS_LBV))[gtid] = e0 / (e0 + e1); }
  for (size_t i = gtid; i < (size_t)T * 8; i += gth) { const int t = (int)(i >> 3), j = (int)(i & 7);
    const double inv = pow(500000.0, -(double)(2 * j) / 16.0), ang = (double)p.pos[t] * inv;
    ((float2*)(p.ws + WS_CS))[i] = make_float2((float)cos(ang), (float)sin(ang)); }
  LAS float* scr = (LAS float*)lds;
  constexpr int T_IN = 16 * 64, T_O = 16 * 16, T_Q = 16 * 16, T_KV = 16 * 8, T_SWO = 16 * 16, NT_ALL = T_IN + T_O + T_Q + T_KV + T_SWO;
  for (int it = bid; it < NT_ALL; it += nb) {
    int r = it;
    if (r < T_IN) { transpose_tile(p.hg_w_in, 1024, 4096, (bf16_t*)(p.ws + WS_WT_IN), 0, r, scr, tid); continue; } r -= T_IN;
    if (r < T_O) { transpose_tile(p.hg_w_o, 1024, 1024, (bf16_t*)(p.ws + WS_WT_O), 0, r, scr, tid); continue; } r -= T_O;
    if (r < T_Q) { transpose_tile(p.sw_w_q, 1024, 1024, (bf16_t*)(p.ws + WS_WT_QKV), 0, r, scr, tid); continue; } r -= T_Q;
    if (r < T_KV) { transpose_tile(p.w_kv, 1024, 512, (bf16_t*)(p.ws + WS_WT_QKV), 1024, r, scr, tid); continue; } r -= T_KV;
    transpose_tile(p.sw_w_o, 1024, 1024, (bf16_t*)(p.ws + WS_WT_SWO), 0, r, scr, tid);
  }
  for (int it = bid; it < 512; it += nb) peer_fold_item(p, it, scr, tid);
  cvt_stream(p.x, (bf16_t*)(p.ws + WS_HB16), (size_t)T * D, gtid, gth);
  cvt_rows_fp8(p.peer_u, p.ws + WS_TABU, (float*)(p.ws + WS_SCL), 32768, bid * 8 + (tid >> 6), nb * 8, tid & 63);
  cvt_rows_fp8(p.peer_v, p.ws + WS_TABV, (float*)(p.ws + WS_SCL) + 32768, 32768, bid * 8 + (tid >> 6), nb * 8, tid & 63);
}
struct EpiHgrn {
  static constexpr bool PERM = true, AFTER_DRAIN = false;
  unsigned char* ws; float* lf; const float* lbv;
  __device__ __forceinline__ void operator()(const f32x4 (&acc)[2][2][4][2], const Unit& u, int wr, int wc, int fr, int fq) const {
    const int sec = u.pn >> 2, row0 = u.pm * 256 + wr * 64 + fr, col0 = (u.pn & 3) * 256 + wc * 32 + 8 * fq;
    if (sec == 1) {
      float lb[2][8];
#pragma unroll
      for (int bj = 0; bj < 2; ++bj) { const f32x4 a = *(const f32x4*)(lbv + col0 + bj * 128), b = *(const f32x4*)(lbv + col0 + bj * 128 + 4);
        lb[bj][0] = a.x; lb[bj][1] = a.y; lb[bj][2] = a.z; lb[bj][3] = a.w; lb[bj][4] = b.x; lb[bj][5] = b.y; lb[bj][6] = b.z; lb[bj][7] = b.w; }
#pragma unroll
      for (int ai = 0; ai < 2; ++ai)
#pragma unroll
        for (int m = 0; m < 4; ++m) { float* rowp = lf + (size_t)(row0 + ai * 128 + m * 16) * 1024 + col0;
#pragma unroll
          for (int bj = 0; bj < 2; ++bj) { f32x4 o[2];
#pragma unroll
            for (int n = 0; n < 2; ++n)
#pragma unroll
              for (int j = 0; j < 4; ++j) { const float l = lb[bj][4 * n + j]; o[n][j] = __logf(l + (1.0f - l) * fast_sigmoid(acc[ai][bj][m][n][j])); }
            *(f32x4*)(rowp + bj * 128) = o[0]; *(f32x4*)(rowp + bj * 128 + 4) = o[1]; } }
    } else {
      const size_t doff = sec == 0 ? R_QS : (sec == 2 ? R_VI : R_GS);
      bf16_t* dst = (bf16_t*)(ws + doff);
#pragma unroll
      for (int ai = 0; ai < 2; ++ai)
#pragma unroll
        for (int m = 0; m < 4; ++m) { bf16_t* rowp = dst + (size_t)(row0 + ai * 128 + m * 16) * 1024 + col0;
#pragma unroll
          for (int bj = 0; bj < 2; ++bj) { f32x4 v0 = acc[ai][bj][m][0], v1 = acc[ai][bj][m][1];
            if (sec != 2) {
#pragma unroll
              for (int j = 0; j < 4; ++j) { v0[j] = fast_silu(v0[j]); v1[j] = fast_silu(v1[j]); } }
            u32x4 w; w.x = cvt_pk_bf16(v0[0], v0[1]); w.y = cvt_pk_bf16(v0[2], v0[3]); w.z = cvt_pk_bf16(v1[0], v1[1]); w.w = cvt_pk_bf16(v1[2], v1[3]);
            *(u32x4*)(rowp + bj * 128) = w; } }
    }
  }
};
struct EpiResid {
  static constexpr bool PERM = false, AFTER_DRAIN = false;
  const float* res; float* z;
  __device__ __forceinline__ void operator()(const f32x4 (&acc)[2][2][4][2], const Unit& u, int wr, int wc, int fr, int fq) const {
    const int row0 = u.pm * 256 + wr * 64 + fr, col0 = u.pn * 256 + wc * 32 + 4 * fq;
#pragma unroll
    for (int ai = 0; ai < 2; ++ai)
#pragma unroll
      for (int m = 0; m < 4; ++m) { const size_t off = (size_t)(row0 + ai * 128 + m * 16) * 1024 + col0;
#pragma unroll
        for (int bj = 0; bj < 2; ++bj)
#pragma unroll
          for (int n = 0; n < 2; ++n) { const f32x4 r = *(const f32x4*)(res + off + bj * 128 + n * 16); *(f32x4*)(z + off + bj * 128 + n * 16) = acc[ai][bj][m][n] + ALPHA * r; } }
  }
};
struct EpiF32 {
  static constexpr bool PERM = false, AFTER_DRAIN = false;
  float* C; int ldc;
  __device__ __forceinline__ void operator()(const f32x4 (&acc)[2][2][4][2], const Unit& u, int wr, int wc, int fr, int fq) const {
    const int row0 = u.pm * 256 + wr * 64 + fr, col0 = u.pn * 256 + wc * 32 + 4 * fq;
#pragma unroll
    for (int ai = 0; ai < 2; ++ai)
#pragma unroll
      for (int m = 0; m < 4; ++m) { float* rowp = C + (size_t)(row0 + ai * 128 + m * 16) * ldc + col0;
#pragma unroll
        for (int bj = 0; bj < 2; ++bj)
#pragma unroll
          for (int n = 0; n < 2; ++n) *(f32x4*)(rowp + bj * 128 + n * 16) = acc[ai][bj][m][n]; }
  }
};

template <class Epi>
__device__ __forceinline__ void run_gemm(LAS unsigned char* lds, const bf16_t* A, const bf16_t* Bt, int M, int N, int K, const Epi& E, int bid, int nb) {
  pg8::Gemm g; g.A = A; g.Bt = Bt; g.M = M; g.N = N; g.K = K;
  pg8::StaticOrder S; S.init(M, N, nb, bid);
  pg8::gemm_phase<Epi, pg8::StaticOrder, false>(lds, g, S, E, nullptr);
}
__device__ __forceinline__ void phase_gemm1(const P& p, LAS unsigned char* lds, int bid, int nb) {
  EpiHgrn E; E.ws = p.ws; E.lf = (float*)(p.ws + R_LF); E.lbv = (const float*)(p.ws + WS_LBV);
  run_gemm(lds, (const bf16_t*)(p.ws + WS_HB16), (const bf16_t*)(p.ws + WS_WT_IN), T, 4096, 1024, E, bid, nb);
}
#define MFMA32(a, b, c) __builtin_amdgcn_mfma_f32_32x32x16_bf16((a), (b), (c), 0, 0, 0)
constexpr int A_QD = 0, A_KD = 17408, A_KLT = 34816, A_VT = 53248, A_P = 71680, A_TOT = 80896;
__device__ __forceinline__ void phase_hgrn_a(const P& p, LAS unsigned char* lds, int bid, int nb) {
  const int tid = pg8::opaque_tid(), lane = tid & 63, wid = __builtin_amdgcn_readfirstlane(tid >> 6), l31 = lane & 31, hh = lane >> 5;
  LAS bf16_t* qdL = (LAS bf16_t*)(lds + A_QD); LAS bf16_t* kdL = (LAS bf16_t*)(lds + A_KD); LAS bf16_t* klT = (LAS bf16_t*)(lds + A_KLT);
  LAS bf16_t* vT = (LAS bf16_t*)(lds + A_VT); LAS bf16_t* PL = (LAS bf16_t*)(lds + A_P); LAS float* tot = (LAS float*)(lds + A_TOT);
  bf16_t* qs = (bf16_t*)(p.ws + R_QS); const float* lf = (const float*)(p.ws + R_LF); bf16_t* vi = (bf16_t*)(p.ws + R_VI);
  bf16_t* ST = (bf16_t*)(p.ws + R_ST); float* decs = (float*)(p.ws + R_DEC);
  const int d = tid & 127, rg = tid >> 7;
  for (int ch = bid; ch < 2048; ch += nb) {
    const int n = ch & 63, h = (ch >> 6) & 7, b = ch >> 9;
    const size_t t0 = (size_t)b * SEQ + n * 64;
    const size_t g0 = (t0 + rg * 16) * 1024 + h * 128 + d;
    float lfv[16], qv[16], vv[16];
#pragma unroll
    for (int r = 0; r < 16; ++r) { lfv[r] = lf[g0 + (size_t)r * 1024]; qv[r] = bf2f(qs[g0 + (size_t)r * 1024]); vv[r] = bf2f(vi[g0 + (size_t)r * 1024]); }
    float bl[16]; float run = 0.f;
#pragma unroll
    for (int r = 0; r < 16; ++r) { run += lfv[r]; bl[r] = run; }
    tot[rg * 128 + d] = run;
    __syncthreads();
    float off = 0.f, total = 0.f;
#pragma unroll
    for (int g = 0; g < 4; ++g) { const float tg = tot[g * 128 + d]; off += (g < rg) ? tg : 0.f; total += tg; }
    unsigned klp[8], vtp[8];
#pragma unroll
    for (int r = 0; r < 16; r += 2) {
      float qd2[2], kd2[2], kl2[2];
#pragma unroll
      for (int u = 0; u < 2; ++u) { const float bb = off + bl[r + u], k = 1.0f - fast_exp(lfv[r + u]);
        qd2[u] = qv[r + u] * fast_exp(bb); kd2[u] = k * fast_exp(-bb); kl2[u] = k * fast_exp(total - bb); }
      const unsigned qq = cvt_pk_bf16(qd2[0], qd2[1]), kk = cvt_pk_bf16(kd2[0], kd2[1]);
      qdL[(rg * 16 + r) * 136 + d] = (bf16_t)(qq & 0xffffu); qdL[(rg * 16 + r + 1) * 136 + d] = (bf16_t)(qq >> 16);
      kdL[(rg * 16 + r) * 136 + d] = (bf16_t)(kk & 0xffffu); kdL[(rg * 16 + r + 1) * 136 + d] = (bf16_t)(kk >> 16);
      qs[g0 + (size_t)r * 1024] = (bf16_t)(qq & 0xffffu); qs[g0 + (size_t)(r + 1) * 1024] = (bf16_t)(qq >> 16);
      klp[r >> 1] = cvt_pk_bf16(kl2[0], kl2[1]); vtp[r >> 1] = cvt_pk_bf16(vv[r], vv[r + 1]);
    }
    *(LAS u32x4*)(klT + d * 72 + rg * 16) = (u32x4){klp[0], klp[1], klp[2], klp[3]}; *(LAS u32x4*)(klT + d * 72 + rg * 16 + 8) = (u32x4){klp[4], klp[5], klp[6], klp[7]};
    *(LAS u32x4*)(vT + d * 72 + rg * 16) = (u32x4){vtp[0], vtp[1], vtp[2], vtp[3]}; *(LAS u32x4*)(vT + d * 72 + rg * 16 + 8) = (u32x4){vtp[4], vtp[5], vtp[6], vtp[7]};
    if (rg == 0) decs[(size_t)ch * 128 + d] = fast_exp(total);
    __syncthreads();
    if (wid < 3) {
      const int jt = (wid == 2) ? 1 : 0, it = (wid == 0) ? 0 : 1;
      f32x16 c; for (int i = 0; i < 16; ++i) c[i] = 0.f;
#pragma unroll
      for (int ks = 0; ks < 8; ++ks) { const bf16x8 a = *(const LAS bf16x8*)(kdL + (jt * 32 + l31) * 136 + ks * 16 + hh * 8), bq = *(const LAS bf16x8*)(qdL + (it * 32 + l31) * 136 + ks * 16 + hh * 8);
        c = MFMA32(a, bq, c); }
      const int i = it * 32 + l31;
#pragma unroll
      for (int g = 0; g < 4; ++g) { const int j0 = jt * 32 + 8 * g + 4 * hh; float v[4];
#pragma unroll
        for (int u = 0; u < 4; ++u) v[u] = (j0 + u <= i) ? c[4 * g + u] : 0.f;
        *(LAS u32x2*)(PL + i * 72 + j0) = (u32x2){cvt_pk_bf16(v[0], v[1]), cvt_pk_bf16(v[2], v[3])}; }
    }
    { const int tbase = (wid >= 3) ? (wid - 3) * 2 : 10 + wid * 2;
#pragma unroll
      for (int tt = 0; tt < 2; ++tt) { const int tile = tbase + tt, et = tile >> 2, dt = tile & 3;
        f32x16 c; for (int i = 0; i < 16; ++i) c[i] = 0.f;
#pragma unroll
        for (int ks = 0; ks < 4; ++ks) { const bf16x8 a = *(const LAS bf16x8*)(vT + (et * 32 + l31) * 72 + ks * 16 + hh * 8), bk = *(const LAS bf16x8*)(klT + (dt * 32 + l31) * 72 + ks * 16 + hh * 8);
          c = MFMA32(a, bk, c); }
        bf16_t* dst = ST + ((size_t)ch * 128 + et * 32 + 4 * hh) * 128 + dt * 32 + l31;
#pragma unroll
        for (int g = 0; g < 4; ++g)
#pragma unroll
          for (int u = 0; u < 4; u += 2) { const unsigned w = cvt_pk_bf16(c[4 * g + u], c[4 * g + u + 1]);
            dst[(size_t)(8 * g + u) * 128] = (bf16_t)(w & 0xffffu); dst[(size_t)(8 * g + u + 1) * 128] = (bf16_t)(w >> 16); } }
    }
    __syncthreads();
    { const int it = wid >> 2, et = wid & 3;
      f32x16 c; for (int i = 0; i < 16; ++i) c[i] = 0.f;
#pragma unroll
      for (int ks = 0; ks < 4; ++ks) if (ks < 2 + 2 * it) { const bf16x8 a = *(const LAS bf16x8*)(PL + (it * 32 + l31) * 72 + ks * 16 + hh * 8), bv = *(const LAS bf16x8*)(vT + (et * 32 + l31) * 72 + ks * 16 + hh * 8);
        c = MFMA32(a, bv, c); }
      bf16_t* dst = vi + (t0 + it * 32 + 4 * hh) * 1024 + h * 128 + et * 32 + l31;
#pragma unroll
      for (int g = 0; g < 4; ++g)
#pragma unroll
        for (int u = 0; u < 4; u += 2) { const unsigned w = cvt_pk_bf16(c[4 * g + u], c[4 * g + u + 1]);
          dst[(size_t)(8 * g + u) * 1024] = (bf16_t)(w & 0xffffu); dst[(size_t)(8 * g + u + 1) * 1024] = (bf16_t)(w >> 16); }
    }
  }
}
__device__ __forceinline__ void phase_hgrn_b(const P& p, int bid, int nb) {
  bf16_t* ST = (bf16_t*)(p.ws + R_ST); const float* decs = (const float*)(p.ws + R_DEC);
  for (size_t it = (size_t)bid * NTHR + pg8::opaque_tid(); it < 131072; it += (size_t)nb * NTHR) {
    const int bh = (int)(it >> 12), quad = (int)(it & 4095), d4 = (quad & 31) * 4;
    bf16_t* base = ST + (size_t)bh * 64 * 16384 + quad * 4; const float* dbase = decs + (size_t)bh * 64 * 128 + d4;
    float s0 = 0.f, s1 = 0.f, s2 = 0.f, s3 = 0.f;
#pragma unroll 8
    for (int n = 0; n < 64; ++n) {
      const u32x2 loc = *(const u32x2*)(base + (size_t)n * 16384); const f32x4 dc = *(const f32x4*)(dbase + n * 128);
      *(u32x2*)(base + (size_t)n * 16384) = (u32x2){cvt_pk_bf16(s0, s1), cvt_pk_bf16(s2, s3)};
      s0 = s0 * dc.x + bflo(loc.x); s1 = s1 * dc.y + bfhi(loc.x); s2 = s2 * dc.z + bflo(loc.y); s3 = s3 * dc.w + bfhi(loc.y);
    }
  }
}
__device__ __forceinline__ void phase_hgrn_c(const P& p, int bid, int nb) {
  const int tid = pg8::opaque_tid(), lane = tid & 63, wid = tid >> 6, l31 = lane & 31, hh = lane >> 5;
  const bf16_t* qd = (const bf16_t*)(p.ws + R_QS); bf16_t* oi = (bf16_t*)(p.ws + R_VI); const bf16_t* gs = (const bf16_t*)(p.ws + R_GS); const bf16_t* ST = (const bf16_t*)(p.ws + R_ST);
  for (int wt = bid * 8 + wid; wt < 4096; wt += nb * 8) {
    const int ch = wt >> 1, half = wt & 1, n = ch & 63, h = (ch >> 6) & 7, b = ch >> 9;
    const size_t trow = ((size_t)b * SEQ + n * 64 + half * 32 + l31) * 1024 + h * 128;
    bf16x8 bq[8];
#pragma unroll
    for (int ks = 0; ks < 8; ++ks) bq[ks] = *(const bf16x8*)(qd + trow + ks * 16 + hh * 8);
    f32x16 acc[4];
#pragma unroll
    for (int et = 0; et < 4; ++et) {
      for (int i = 0; i < 16; ++i) acc[et][i] = 0.f;
      const bf16_t* ap = ST + ((size_t)ch * 128 + et * 32 + l31) * 128 + hh * 8;
#pragma unroll
      for (int ks = 0; ks < 8; ++ks) { const bf16x8 a = *(const bf16x8*)(ap + ks * 16); acc[et] = MFMA32(a, bq[ks], acc[et]); }
    }
    float ss = 0.f;
#pragma unroll
    for (int et = 0; et < 4; ++et)
#pragma unroll
      for (int g = 0; g < 4; ++g) { const u32x2 w = *(const u32x2*)(oi + trow + et * 32 + 8 * g + 4 * hh);
        acc[et][4 * g] += bflo(w.x); acc[et][4 * g + 1] += bfhi(w.x); acc[et][4 * g + 2] += bflo(w.y); acc[et][4 * g + 3] += bfhi(w.y);
        ss += acc[et][4 * g] * acc[et][4 * g] + acc[et][4 * g + 1] * acc[et][4 * g + 1] + acc[et][4 * g + 2] * acc[et][4 * g + 2] + acc[et][4 * g + 3] * acc[et][4 * g + 3]; }
    ss += __shfl_xor(ss, 32);
    const float r = rsqrtf(ss * (1.0f / 128.0f) + 1e-6f);
#pragma unroll
    for (int et = 0; et < 4; ++et)
#pragma unroll
      for (int g = 0; g < 4; ++g) { const int e0 = et * 32 + 8 * g + 4 * hh; const f32x4 nw = *(const f32x4*)(p.hg_norm_w + h * 128 + e0); const u32x2 gw = *(const u32x2*)(gs + trow + e0);
        const float o0 = acc[et][4 * g] * r * nw.x * bflo(gw.x), o1 = acc[et][4 * g + 1] * r * nw.y * bfhi(gw.x), o2 = acc[et][4 * g + 2] * r * nw.z * bflo(gw.y), o3 = acc[et][4 * g + 3] * r * nw.w * bfhi(gw.y);
        *(u32x2*)(oi + trow + e0) = (u32x2){cvt_pk_bf16(o0, o1), cvt_pk_bf16(o2, o3)}; }
  }
}
__device__ __forceinline__ void phase_gemm2(const P& p, LAS unsigned char* lds, int bid, int nb) {
  EpiResid E; E.res = p.x; E.z = (float*)(p.ws + R_Z);
  run_gemm(lds, (const bf16_t*)(p.ws + R_VI), (const bf16_t*)(p.ws + WS_WT_O), T, 1024, 1024, E, bid, nb);
}
__device__ __forceinline__ void phase_ln(const float* __restrict__ z, const float* __restrict__ g, const float* __restrict__ bb, float* __restrict__ hout, bf16_t* __restrict__ hb, int bid, int nb) {
  const int tid_ = pg8::opaque_tid(), lane = tid_ & 63, wid = tid_ >> 6;
  for (int t = bid * 8 + wid; t < T; t += nb * 8) {
    f32x4 v[4]; float s = 0.f;
#pragma unroll
    for (int r = 0; r < 4; ++r) { v[r] = *(const f32x4*)(z + (size_t)t * 1024 + r * 256 + lane * 4); s += (v[r].x + v[r].y) + (v[r].z + v[r].w); }
    const float mu = wave_sum(s) * (1.0f / 1024.0f); float q = 0.f;
#pragma unroll
    for (int r = 0; r < 4; ++r) { v[r] = v[r] - mu; q += (v[r].x * v[r].x + v[r].y * v[r].y) + (v[r].z * v[r].z + v[r].w * v[r].w); }
    const float rs = rsqrtf(wave_sum(q) * (1.0f / 1024.0f) + 1e-5f);
#pragma unroll
    for (int r = 0; r < 4; ++r) { const int c = r * 256 + lane * 4; const f32x4 gg = *(const f32x4*)(g + c), b4 = *(const f32x4*)(bb + c);
      const f32x4 o = v[r] * rs * gg + b4;
      *(f32x4*)(hout + (size_t)t * 1024 + c) = o;
      *(u32x2*)(hb + (size_t)t * 1024 + c) = (u32x2){cvt_pk_bf16(o.x, o.y), cvt_pk_bf16(o.z, o.w)}; }
  }
}
typedef __bf16 bf16x2_t __attribute__((ext_vector_type(2)));
__device__ __forceinline__ float dot2bf(unsigned a, unsigned b, float c) { return __builtin_amdgcn_fdot2_f32_bf16(__builtin_bit_cast(bf16x2_t, a), __builtin_bit_cast(bf16x2_t, b), c, false); }
__device__ __forceinline__ void phase_peer_scores(const P& p, int l, LAS unsigned char* lds, int bid, int nb) {
  EpiF32 E; E.C = (float*)(p.ws + R_SC); E.ldc = 2048;
  run_gemm(lds, (const bf16_t*)(p.ws + WS_HB16), (const bf16_t*)(p.ws + WS_WT_PEER) + (size_t)l * 2048 * 1024, T, 2048, 1024, E, bid, nb);
}
__device__ __forceinline__ void fp8x16_to_f32(const u32x4& w, float (&f)[16]) {
  const unsigned ww[4] = {w.x, w.y, w.z, w.w};
#pragma unroll
  for (int i = 0; i < 4; ++i) { const f32x2 lo = __builtin_amdgcn_cvt_pk_f32_fp8((int)ww[i], false), hi = __builtin_amdgcn_cvt_pk_f32_fp8((int)ww[i], true);
    f[4 * i] = lo.x; f[4 * i + 1] = lo.y; f[4 * i + 2] = hi.x; f[4 * i + 3] = hi.y; }
}
#define CE(a, b) do { const unsigned mx_ = (a) > (b) ? (a) : (b), mn_ = (a) > (b) ? (b) : (a); (a) = mx_; (b) = mn_; } while (0)
__device__ __forceinline__ unsigned f2ord(float f) { const unsigned u = __float_as_uint(f); return u ^ ((unsigned)((int)u >> 31) | 0x80000000u); }
__device__ __forceinline__ float ord2f(unsigned o) { return __uint_as_float(o ^ ((o & 0x80000000u) ? 0x80000000u : 0xffffffffu)); }
__device__ __forceinline__ void sort16_desc(unsigned (&k)[16]) { CE(k[0], k[1]); CE(k[2], k[3]); CE(k[0], k[2]); CE(k[1], k[3]); CE(k[1], k[2]); CE(k[4], k[5]); CE(k[6], k[7]); CE(k[4], k[6]); CE(k[5], k[7]); CE(k[5], k[6]); CE(k[0], k[4]); CE(k[2], k[6]); CE(k[2], k[4]); CE(k[1], k[5]); CE(k[3], k[7]); CE(k[3], k[5]); CE(k[1], k[2]); CE(k[3], k[4]); CE(k[5], k[6]); CE(k[8], k[9]); CE(k[10], k[11]); CE(k[8], k[10]); CE(k[9], k[11]); CE(k[9], k[10]); CE(k[12], k[13]); CE(k[14], k[15]); CE(k[12], k[14]); CE(k[13], k[15]); CE(k[13], k[14]); CE(k[8], k[12]); CE(k[10], k[14]); CE(k[10], k[12]); CE(k[9], k[13]); CE(k[11], k[15]); CE(k[11], k[13]); CE(k[9], k[10]); CE(k[11], k[12]); CE(k[13], k[14]); CE(k[0], k[8]); CE(k[4], k[12]); CE(k[4], k[8]); CE(k[2], k[10]); CE(k[6], k[14]); CE(k[6], k[10]); CE(k[2], k[4]); CE(k[6], k[8]); CE(k[10], k[12]); CE(k[1], k[9]); CE(k[5], k[13]); CE(k[5], k[9]); CE(k[3], k[11]); CE(k[7], k[15]); CE(k[7], k[11]); CE(k[3], k[5]); CE(k[7], k[9]); CE(k[11], k[13]); CE(k[1], k[2]); CE(k[3], k[4]); CE(k[5], k[6]); CE(k[7], k[8]); CE(k[9], k[10]); CE(k[11], k[12]); CE(k[13], k[14]); }
__device__ __forceinline__ void bitonic_merge16_desc(unsigned (&k)[16]) {
#pragma unroll
  for (int s = 8; s >= 1; s >>= 1)
#pragma unroll
    for (int i = 0; i < 16; ++i) if ((i & s) == 0) CE(k[i], k[i + s]);
}
__device__ __forceinline__ void merge_top16(unsigned (&a)[16], const unsigned (&b)[16]) {
#pragma unroll
  for (int i = 0; i < 16; ++i) a[i] = a[i] > b[15 - i] ? a[i] : b[15 - i];
  bitonic_merge16_desc(a);
}
__device__ __forceinline__ void xchg16(unsigned (&dst)[16], const unsigned (&src)[16], int mask) {
#pragma unroll
  for (int i = 0; i < 16; ++i) dst[i] = (unsigned)__shfl_xor((int)src[i], mask);
}
__device__ __forceinline__ void phase_peer_topk(const P& p, int l, int bid, int nb) {
  const int tid_ = pg8::opaque_tid(), lane = tid_ & 63, wid = tid_ >> 6, part = lane & 3, r = lane & 7;
  const float* sc = (const float*)(p.ws + R_SC); unsigned* rkey = (unsigned*)(p.ws + R_EIDX); float* rsu = (float*)(p.ws + R_GATE);
  const float* sclu = (const float*)(p.ws + WS_SCL) + l * 16384; const float* sclv = (const float*)(p.ws + WS_SCL) + 32768 + l * 16384;
  for (int t = bid * 8 + wid; t < T; t += nb * 8) {
    const float* src = sc + (size_t)t * 2048 + (lane >> 2) * 128 + part * 4;
    unsigned a[16], b[16];
#pragma unroll
    for (int i = 0; i < 4; ++i) { const f32x4 v = *(const f32x4*)(src + 16 * i); const int e0 = 127 - 16 * i - 4 * part;
      a[4 * i] = (f2ord(v.x) & ~127u) | (unsigned)e0; a[4 * i + 1] = (f2ord(v.y) & ~127u) | (unsigned)(e0 - 1); a[4 * i + 2] = (f2ord(v.z) & ~127u) | (unsigned)(e0 - 2); a[4 * i + 3] = (f2ord(v.w) & ~127u) | (unsigned)(e0 - 3); }
#pragma unroll
    for (int i = 0; i < 4; ++i) { const f32x4 v = *(const f32x4*)(src + 64 + 16 * i); const int e0 = 127 - 64 - 16 * i - 4 * part;
      b[4 * i] = (f2ord(v.x) & ~127u) | (unsigned)e0; b[4 * i + 1] = (f2ord(v.y) & ~127u) | (unsigned)(e0 - 1); b[4 * i + 2] = (f2ord(v.z) & ~127u) | (unsigned)(e0 - 2); b[4 * i + 3] = (f2ord(v.w) & ~127u) | (unsigned)(e0 - 3); }
    sort16_desc(a); sort16_desc(b); merge_top16(a, b);
    xchg16(b, a, 1); merge_top16(a, b);
    xchg16(b, a, 2); merge_top16(a, b);
    xchg16(b, a, 4);
    const bool second = (lane & 4) != 0;
    unsigned k1[16], k2[16];
#pragma unroll
    for (int i = 0; i < 16; ++i) { k1[i] = second ? b[i] : a[i]; k2[i] = second ? a[i] : b[i]; }
    float v2[16];
#pragma unroll
    for (int i = 0; i < 16; ++i) v2[i] = ord2f(k2[i] & ~127u);
    unsigned k1r = k1[0], k1x = k1[8];
#pragma unroll
    for (int j = 1; j < 8; ++j) { k1r = (r == j) ? k1[j] : k1r; k1x = (r == j) ? k1[8 + j] : k1x; }
    const float v1r = ord2f(k1r & ~127u), v1x = ord2f(k1x & ~127u), vmax = ord2f(k1[0] & ~127u) + v2[0];
    unsigned ck[16]; float cs_[16];
#pragma unroll
    for (int bb = 0; bb < 16; ++bb) { cs_[bb] = v1r + v2[bb]; const bool valid = (r + 1) * (bb + 1) <= 16;
      ck[bb] = valid ? ((f2ord(cs_[bb]) & ~255u) | (unsigned)(255 - (r * 16 + bb))) : 0u; }
    const float sx = v1x + v2[0]; const unsigned xk = (f2ord(sx) & ~255u) | (unsigned)(255 - ((8 + r) * 16));
    unsigned m[16];
#pragma unroll
    for (int i = 0; i < 16; ++i) m[i] = ck[i];
    xchg16(b, m, 1); merge_top16(m, b); xchg16(b, m, 2); merge_top16(m, b); xchg16(b, m, 4); merge_top16(m, b);
#pragma unroll
    for (int j = 0; j < 8; ++j) b[j] = (unsigned)__shfl((int)xk, (lane & ~7) + j);
#pragma unroll
    for (int j = 8; j < 16; ++j) b[j] = 0u;
    merge_top16(m, b);
    const unsigned t16 = m[15];
    int cnt = 0; float es = 0.f; float ev[16];
#pragma unroll
    for (int bb = 0; bb < 16; ++bb) { const bool sel = ck[bb] >= t16 && ck[bb] != 0u; ev[bb] = sel ? fast_exp(cs_[bb] - vmax) : 0.f; es += ev[bb]; cnt += sel ? 1 : 0; }
    const bool selx = xk >= t16; const float evx = selx ? fast_exp(sx - vmax) : 0.f; es += evx;
    const int tot = cnt + (selx ? 1 : 0);
    int off = 0;
#pragma unroll
    for (int j = 0; j < 8; ++j) { const int tj = __shfl(tot, (lane & ~7) + j); off += (j < r) ? tj : 0; }
    es += __shfl_xor(es, 1); es += __shfl_xor(es, 2); es += __shfl_xor(es, 4);
    const float inv = 1.0f / es;
    const size_t obase = (size_t)t * 128 + (lane >> 3) * 16 + off;
    const int i1r = 127 - (int)(k1r & 127u), i1x = 127 - (int)(k1x & 127u);
#pragma unroll
    for (int bb = 0; bb < 16; ++bb) if (bb < cnt) { const int e = i1r * 128 + (127 - (int)(k2[bb] & 127u)); rkey[obase + bb] = ((unsigned)e << 18) | (cvt_pk_bf16(ev[bb] * inv * sclv[e], 0.f) & 0xffffu); rsu[obase + bb] = sclu[e]; }
    if (selx) { const int e = i1x * 128 + (127 - (int)(k2[0] & 127u)); rkey[obase + cnt] = ((unsigned)e << 18) | (cvt_pk_bf16(evx * inv * sclv[e], 0.f) & 0xffffu); rsu[obase + cnt] = sclu[e]; }
  }
}
#define CE2(ka, pa, kb, pb) do { const bool sw_ = (kb) < (ka); const unsigned k0_ = sw_ ? (kb) : (ka), k1_ = sw_ ? (ka) : (kb), p0_ = sw_ ? (pb) : (pa), p1_ = sw_ ? (pa) : (pb); \
    (ka) = k0_; (kb) = k1_; (pa) = p0_; (pb) = p1_; } while (0)
template <int R>
__device__ __forceinline__ void sort_wave(unsigned (&k)[R], unsigned (&pl)[R], int lane) {
#pragma unroll
  for (int kk = 2; kk <= 64 * R; kk <<= 1) {
    { const int m = kk - 1;
      if (m < R) {
#pragma unroll
        for (int r = 0; r < R; ++r) { const int r2 = r ^ m; if (r2 > r) CE2(k[r], pl[r], k[r2], pl[r2]); }
      } else {
        const int lm = m / R; const bool lower = (lane & ((lm + 1) >> 1)) == 0;
        unsigned nk[R], np[R];
#pragma unroll
        for (int r = 0; r < R; ++r) { const unsigned pk = (unsigned)__shfl_xor((int)k[R - 1 - r], lm), pp = (unsigned)__shfl_xor((int)pl[R - 1 - r], lm);
          const bool take = lower ? (pk < k[r]) : (pk > k[r]); nk[r] = take ? pk : k[r]; np[r] = take ? pp : pl[r]; }
#pragma unroll
        for (int r = 0; r < R; ++r) { k[r] = nk[r]; pl[r] = np[r]; }
      } }
#pragma unroll
    for (int j = kk >> 2; j >= 1; j >>= 1) {
      if (j < R) {
#pragma unroll
        for (int r = 0; r < R; ++r) { const int r2 = r ^ j; if (r2 > r) CE2(k[r], pl[r], k[r2], pl[r2]); }
      } else {
        const int lm = j / R; const bool lower = (lane & lm) == 0;
#pragma unroll
        for (int r = 0; r < R; ++r) { const unsigned pk = (unsigned)__shfl_xor((int)k[r], lm), pp = (unsigned)__shfl_xor((int)pl[r], lm);
          const bool take = lower ? (pk < k[r]) : (pk > k[r]); k[r] = take ? pk : k[r]; pl[r] = take ? pp : pl[r]; }
      }
    }
  }
}
__device__ __forceinline__ float swap32_sum(float a, float b) { const u32x2 r = __builtin_amdgcn_permlane32_swap(__float_as_uint(a), __float_as_uint(b), false, false); return __uint_as_float(r.x) + __uint_as_float(r.y); }
__device__ __forceinline__ float swap16_sum(float a, float b) { const u32x2 r = __builtin_amdgcn_permlane16_swap(__float_as_uint(a), __float_as_uint(b), false, false); return __uint_as_float(r.x) + __uint_as_float(r.y); }
#define DPP_F(x, ctrl) __int_as_float(__builtin_amdgcn_update_dpp(0, __float_as_int(x), (ctrl), 0xf, 0xf, false))
constexpr int GNT = 2, GR = 2 * GNT;
struct GB8 { u32x4 r[8]; };
__device__ __forceinline__ unsigned gb_key(const unsigned (&k)[GR], int b, int q) { return (unsigned)__builtin_amdgcn_readlane((int)k[q & 3], 2 * b + (q >> 2)); }
__device__ __forceinline__ void gb8_load(GB8& B, const unsigned (&k)[GR], int b, const unsigned char* tab, int lane) {
#pragma unroll
  for (int q = 0; q < 8; ++q) { const size_t off = (size_t)(gb_key(k, b, q) >> 18) * 1024 + lane * 16; B.r[q] = *(const u32x4*)(tab + off); }
}
__device__ __forceinline__ void gb8_compute(const GB8& B, const GB8& V, const unsigned (&k)[GR], const unsigned (&su)[GR], int b, const f32x2 (&xa)[8], const f32x2 (&xb)[8], f32x2 (&acc0)[8], f32x2 (&acc1)[8], int lane) {
  float part[8];
#pragma unroll
  for (int q = 0; q < 8; ++q) { const bool s1_ = ((gb_key(k, b, q) >> 16) & 1u) != 0u;
    const unsigned ww[4] = {B.r[q].x, B.r[q].y, B.r[q].z, B.r[q].w}; f32x2 d0 = {0.f, 0.f}, d1 = {0.f, 0.f};
#pragma unroll
    for (int i = 0; i < 4; ++i) { const f32x2 fa = __builtin_amdgcn_cvt_pk_f32_fp8((int)ww[i], false), fb = __builtin_amdgcn_cvt_pk_f32_fp8((int)ww[i], true);
      d0 += xa[2 * i] * fa; d0 += xa[2 * i + 1] * fb; d1 += xb[2 * i] * fa; d1 += xb[2 * i + 1] * fb; }
    part[q] = s1_ ? (d1.x + d1.y) : (d0.x + d0.y); }
  const float r0 = swap32_sum(part[0], part[4]), r1 = swap32_sum(part[1], part[5]), r2 = swap32_sum(part[2], part[6]), r3 = swap32_sum(part[3], part[7]);
  const float s0 = swap16_sum(r0, r2), s1 = swap16_sum(r1, r3);
  const bool hi8 = (lane & 8) != 0;
  const float keep = hi8 ? s1 : s0, send = hi8 ? s0 : s1;
  float t = keep + DPP_F(send, 0x128);
  t += DPP_F(t, 0xB1); t += DPP_F(t, 0x4E); t += DPP_F(t, 0x141);
  const int g = lane >> 3, src = 2 * b + (g >> 2), rg = g & 3;
  const unsigned ka = (unsigned)__shfl((int)k[0], src), kb = (unsigned)__shfl((int)k[1], src), kc = (unsigned)__shfl((int)k[2], src), kd = (unsigned)__shfl((int)k[3], src);
  const unsigned sa = (unsigned)__shfl((int)su[0], src), sb = (unsigned)__shfl((int)su[1], src), sc_ = (unsigned)__shfl((int)su[2], src), sd = (unsigned)__shfl((int)su[3], src);
  const unsigned kq = rg == 0 ? ka : (rg == 1 ? kb : (rg == 2 ? kc : kd)), sq = rg == 0 ? sa : (rg == 1 ? sb : (rg == 2 ? sc_ : sd));
  const float d = t * __uint_as_float(sq), gsv = __uint_as_float(kq << 16);
  const float wv = gsv * 0.5f * d * (1.0f + erff(d * 0.70710678118f));
#pragma unroll
  for (int q = 0; q < 8; ++q) { const bool s1_ = ((gb_key(k, b, q) >> 16) & 1u) != 0u; const float w = __int_as_float(__builtin_amdgcn_readlane(__float_as_int(wv), 8 * q));
    const float wa = s1_ ? 0.f : w, wb = s1_ ? w : 0.f; const f32x2 w0 = {wa, wa}, w1 = {wb, wb};
    const unsigned ww[4] = {V.r[q].x, V.r[q].y, V.r[q].z, V.r[q].w};
#pragma unroll
    for (int i = 0; i < 4; ++i) { const f32x2 fa = __builtin_amdgcn_cvt_pk_f32_fp8((int)ww[i], false), fb = __builtin_amdgcn_cvt_pk_f32_fp8((int)ww[i], true);
      acc0[2 * i] += w0 * fa; acc0[2 * i + 1] += w0 * fb; acc1[2 * i] += w1 * fa; acc1[2 * i + 1] += w1 * fb; } }
}
__device__ __forceinline__ void phase_peer_gather(const P& p, int l, const float* __restrict__ hin, float* __restrict__ hout, LAS unsigned char* lds, int bid, int nb) {
  const int tid_ = pg8::opaque_tid(), lane = tid_ & 63, wid = __builtin_amdgcn_readfirstlane(tid_ >> 6);
  const unsigned* rkey = (const unsigned*)(p.ws + R_EIDX); const float* rsu = (const float*)(p.ws + R_GATE);
  const unsigned char* tabu = p.ws + WS_TABU + (size_t)l * 16384 * 1024; const unsigned char* tabv = p.ws + WS_TABV + (size_t)l * 16384 * 1024;
  const float* g = p.ln_ffn_g + l * 1024; const float* bb = p.ln_ffn_b + l * 1024; bf16_t* hb = (bf16_t*)(p.ws + WS_HB16);
  for (int tb = (bid * 8 + wid) * GNT; tb < T; tb += nb * 8 * GNT) {
    f32x2 xa[8], xb[8];
#pragma unroll
    for (int c = 0; c < 4; ++c) { const f32x4 a = *(const f32x4*)(hin + (size_t)tb * 1024 + lane * 16 + 4 * c), b4 = *(const f32x4*)(hin + (size_t)(tb + 1) * 1024 + lane * 16 + 4 * c);
      xa[2 * c] = (f32x2){a.x, a.y}; xa[2 * c + 1] = (f32x2){a.z, a.w}; xb[2 * c] = (f32x2){b4.x, b4.y}; xb[2 * c + 1] = (f32x2){b4.z, b4.w}; }
    unsigned k[GR], su[GR];
#pragma unroll
    for (int r = 0; r < GR; ++r) { k[r] = rkey[(size_t)tb * 128 + r * 64 + lane] | ((unsigned)(r >> 1) << 16); su[r] = __float_as_uint(rsu[(size_t)tb * 128 + r * 64 + lane]); }
    sort_wave<GR>(k, su, lane);
    f32x2 acc0[8], acc1[8];
#pragma unroll
    for (int i = 0; i < 8; ++i) { acc0[i] = (f32x2){0.f, 0.f}; acc1[i] = (f32x2){0.f, 0.f}; }
    GB8 A, B, V;
    gb8_load(A, k, 0, tabu, lane);
#pragma unroll 1
    for (int b = 0; b < 32; b += 2) {
      gb8_load(V, k, b, tabv, lane); gb8_load(B, k, b + 1, tabu, lane);
      gb8_compute(A, V, k, su, b, xa, xb, acc0, acc1, lane);
      gb8_load(V, k, b + 1, tabv, lane); gb8_load(A, k, b + 2 < 32 ? b + 2 : 30, tabu, lane);
      gb8_compute(B, V, k, su, b + 1, xa, xb, acc0, acc1, lane);
    }
#pragma unroll
    for (int sl = 0; sl < GNT; ++sl) {
      float z[16]; float s = 0.f;
#pragma unroll
      for (int c = 0; c < 4; ++c) { const f32x2 a0 = sl ? acc1[2 * c] : acc0[2 * c], a1 = sl ? acc1[2 * c + 1] : acc0[2 * c + 1], x0 = sl ? xb[2 * c] : xa[2 * c], x1 = sl ? xb[2 * c + 1] : xa[2 * c + 1];
        z[4 * c] = a0.x + ALPHA * x0.x; z[4 * c + 1] = a0.y + ALPHA * x0.y; z[4 * c + 2] = a1.x + ALPHA * x1.x; z[4 * c + 3] = a1.y + ALPHA * x1.y; }
#pragma unroll
      for (int i = 0; i < 16; ++i) s += z[i];
      const float mu = wave_sum(s) * (1.0f / 1024.0f); float q2 = 0.f;
#pragma unroll
      for (int i = 0; i < 16; ++i) { z[i] -= mu; q2 += z[i] * z[i]; }
      const float rs = rsqrtf(wave_sum(q2) * (1.0f / 1024.0f) + 1e-5f);
      const int cc = lane * 16; const size_t t = (size_t)(tb + sl); f32x4 o[4];
#pragma unroll
      for (int i = 0; i < 4; ++i) { const f32x4 gg = *(const f32x4*)(g + cc + 4 * i), b4 = *(const f32x4*)(bb + cc + 4 * i);
        o[i] = (f32x4){z[4 * i] * rs, z[4 * i + 1] * rs, z[4 * i + 2] * rs, z[4 * i + 3] * rs} * gg + b4;
        *(f32x4*)(hout + t * 1024 + cc + 4 * i) = o[i]; }
      *(u32x4*)(hb + t * 1024 + cc) = (u32x4){cvt_pk_bf16(o[0].x, o[0].y), cvt_pk_bf16(o[0].z, o[0].w), cvt_pk_bf16(o[1].x, o[1].y), cvt_pk_bf16(o[1].z, o[1].w)};
      *(u32x4*)(hb + t * 1024 + cc + 8) = (u32x4){cvt_pk_bf16(o[2].x, o[2].y), cvt_pk_bf16(o[2].z, o[2].w), cvt_pk_bf16(o[3].x, o[3].y), cvt_pk_bf16(o[3].z, o[3].w)};
    }
  }
}
struct EpiAttn {
  static constexpr bool PERM = true, AFTER_DRAIN = false;
  unsigned char* ws; const float* cs;
  __device__ __forceinline__ void operator()(const f32x4 (&acc)[2][2][4][2], const Unit& u, int wr, int wc, int fr, int fq) const {
    const int row0 = u.pm * 256 + wr * 64 + fr;
    if (u.pn < 5) {
      const bool isq = u.pn < 4; const float scale = isq ? 0.125f : 1.0f; const int ld = isq ? 1024 : 256;
      bf16_t* dst = (bf16_t*)(ws + (isq ? R_Q : R_KB)) + (isq ? u.pn * 256 : 0) + wc * 32 + 8 * fq;
      const bool ropewave = (wc & 1) == 0;
#pragma unroll
      for (int ai = 0; ai < 2; ++ai)
#pragma unroll
        for (int m = 0; m < 4; ++m) { const int row = row0 + ai * 128 + m * 16;
          f32x4 c4[4];
          if (ropewave) {
#pragma unroll
            for (int i = 0; i < 4; ++i) c4[i] = *(const f32x4*)(cs + (size_t)row * 16 + i * 4); }
#pragma unroll
          for (int bj = 0; bj < 2; ++bj) { f32x4 v0 = acc[ai][bj][m][0], v1 = acc[ai][bj][m][1];
            if (ropewave) {
              f32x4 p0, p1;
#pragma unroll
              for (int j = 0; j < 4; ++j) { p0[j] = __shfl_xor(v0[j], 16); p1[j] = __shfl_xor(v1[j], 16); }
              const float sg = (fq == 0) ? -1.0f : 1.0f;
              if (fq < 2) {
                v0[0] = v0[0] * c4[0].x + sg * p0[0] * c4[0].y; v0[1] = v0[1] * c4[0].z + sg * p0[1] * c4[0].w; v0[2] = v0[2] * c4[1].x + sg * p0[2] * c4[1].y; v0[3] = v0[3] * c4[1].z + sg * p0[3] * c4[1].w;
                v1[0] = v1[0] * c4[2].x + sg * p1[0] * c4[2].y; v1[1] = v1[1] * c4[2].z + sg * p1[1] * c4[2].w; v1[2] = v1[2] * c4[3].x + sg * p1[2] * c4[3].y; v1[3] = v1[3] * c4[3].z + sg * p1[3] * c4[3].w;
              }
            }
            v0 = v0 * scale; v1 = v1 * scale;
            u32x4 w; w.x = cvt_pk_bf16(v0[0], v0[1]); w.y = cvt_pk_bf16(v0[2], v0[3]); w.z = cvt_pk_bf16(v1[0], v1[1]); w.w = cvt_pk_bf16(v1[2], v1[3]);
            *(u32x4*)(dst + (size_t)row * ld + bj * 128) = w; } }
    } else {
      bf16_t* vT = (bf16_t*)(ws + R_VT);
#pragma unroll
      for (int ai = 0; ai < 2; ++ai)
#pragma unroll
        for (int m = 0; m < 4; ++m) { const int row = row0 + ai * 128 + m * 16, b = row >> 12, s = row & 4095;
#pragma unroll
          for (int bj = 0; bj < 2; ++bj)
#pragma unroll
            for (int n = 0; n < 2; ++n) { const int col = bj * 128 + wc * 32 + 8 * fq + 4 * n;
              bf16_t* d0 = vT + ((size_t)(b * 4 + (col >> 6)) * 64 + (col & 63)) * 4096 + s;
              const unsigned w0 = cvt_pk_bf16(acc[ai][bj][m][n][0], acc[ai][bj][m][n][1]), w1 = cvt_pk_bf16(acc[ai][bj][m][n][2], acc[ai][bj][m][n][3]);
              d0[0] = (bf16_t)(w0 & 0xffffu); d0[4096] = (bf16_t)(w0 >> 16); d0[2 * 4096] = (bf16_t)(w1 & 0xffffu); d0[3 * 4096] = (bf16_t)(w1 >> 16); } }
    }
  }
};
__device__ __forceinline__ void phase_gemm_qkv(const P& p, LAS unsigned char* lds, int bid, int nb) {
  EpiAttn E; E.ws = p.ws; E.cs = (const float*)(p.ws + WS_CS);
  run_gemm(lds, (const bf16_t*)(p.ws + WS_HB16), (const bf16_t*)(p.ws + WS_WT_QKV), T, 1536, 1024, E, bid, nb);
}
__device__ __forceinline__ void phase_attn(const P& p, int bid, int nb) {
  const int tid_ = pg8::opaque_tid(), lane = tid_ & 63, wid = tid_ >> 6, l31 = lane & 31, hh = lane >> 5;
  const bf16_t* q = (const bf16_t*)(p.ws + R_Q); const bf16_t* kb = (const bf16_t*)(p.ws + R_KB); const bf16_t* vT = (const bf16_t*)(p.ws + R_VT); bf16_t* ao = (bf16_t*)(p.ws + R_AO);
  for (int wt = bid * 8 + wid; wt < 8192; wt += nb * 8) {
    const int qb = wt & 127, hq = (wt >> 7) & 15, b = wt >> 11, kvh = hq >> 2, i0 = qb * 32, k0 = i0 - 128;
    const float sink = p.sw_sinks[hq];
    bf16x8 bq[4];
#pragma unroll
    for (int ks = 0; ks < 4; ++ks) bq[ks] = *(const bf16x8*)(q + (size_t)(b * SEQ + i0 + l31) * 1024 + hq * 64 + ks * 16 + hh * 8);
    f32x16 s[5];
#pragma unroll
    for (int kt = 0; kt < 5; ++kt) {
      for (int i = 0; i < 16; ++i) s[kt][i] = 0.f;
      const int kb0 = k0 + kt * 32;
      if (kb0 >= 0) {
        const bf16_t* kp = kb + (size_t)(b * SEQ + kb0 + l31) * 256 + kvh * 64 + hh * 8;
#pragma unroll
        for (int ks = 0; ks < 4; ++ks) { const bf16x8 a = *(const bf16x8*)(kp + ks * 16); s[kt] = MFMA32(a, bq[ks], s[kt]); }
      }
    }
    const int qp = i0 + l31; float m = sink;
#pragma unroll
    for (int kt = 0; kt < 5; ++kt)
#pragma unroll
      for (int r = 0; r < 16; ++r) { const int kp = k0 + kt * 32 + (r & 3) + 8 * (r >> 2) + 4 * hh; const bool valid = (kp >= 0) && (kp <= qp) && (kp > qp - 128);
        s[kt][r] = valid ? s[kt][r] : -INFINITY; m = fmaxf(m, s[kt][r]); }
    m = fmaxf(m, __shfl_xor(m, 32));
    float lsum = 0.f;
#pragma unroll
    for (int kt = 0; kt < 5; ++kt)
#pragma unroll
      for (int r = 0; r < 16; ++r) { const float e = fast_exp(s[kt][r] - m); s[kt][r] = e; lsum += e; }
    lsum += __shfl_xor(lsum, 32); lsum += fast_exp(sink - m);
    f32x16 o[2];
    for (int i = 0; i < 16; ++i) { o[0][i] = 0.f; o[1][i] = 0.f; }
#pragma unroll
    for (int kt = 0; kt < 5; ++kt) {
      const int kb0 = k0 + kt * 32;
      if (kb0 >= 0) {
#pragma unroll
        for (int st = 0; st < 2; ++st) {
          u32x4 pk; pk.x = cvt_pk_bf16(s[kt][8 * st], s[kt][8 * st + 1]); pk.y = cvt_pk_bf16(s[kt][8 * st + 2], s[kt][8 * st + 3]);
          pk.z = cvt_pk_bf16(s[kt][8 * st + 4], s[kt][8 * st + 5]); pk.w = cvt_pk_bf16(s[kt][8 * st + 6], s[kt][8 * st + 7]);
          const bf16x8 pb = __builtin_bit_cast(bf16x8, pk);
#pragma unroll
          for (int et = 0; et < 2; ++et) { const bf16_t* vp = vT + ((size_t)(b * 4 + kvh) * 64 + et * 32 + l31) * 4096 + kb0 + 16 * st + 4 * hh;
            const u32x2 lo = *(const u32x2*)vp, hi = *(const u32x2*)(vp + 8);
            const bf16x8 a = __builtin_bit_cast(bf16x8, (u32x4){lo.x, lo.y, hi.x, hi.y});
            o[et] = MFMA32(a, pb, o[et]); }
        }
      }
    }
    const float inv = 1.0f / lsum;
#pragma unroll
    for (int et = 0; et < 2; ++et)
#pragma unroll
      for (int g = 0; g < 4; ++g)
        *(u32x2*)(ao + (size_t)(b * SEQ + i0 + l31) * 1024 + hq * 64 + et * 32 + 8 * g + 4 * hh) =
            (u32x2){cvt_pk_bf16(o[et][4 * g] * inv, o[et][4 * g + 1] * inv), cvt_pk_bf16(o[et][4 * g + 2] * inv, o[et][4 * g + 3] * inv)};
  }
}
__device__ __forceinline__ void phase_gemm_swo(const P& p, LAS unsigned char* lds, int bid, int nb) {
  EpiResid E; E.res = p.out; E.z = (float*)(p.ws + R_Z);
  run_gemm(lds, (const bf16_t*)(p.ws + R_AO), (const bf16_t*)(p.ws + WS_WT_SWO), T, 1024, 1024, E, bid, nb);
}
#ifndef R_PREP
#define R_PREP 1
#endif
#ifndef R_G1
#define R_G1 1
#endif
#ifndef R_HA
#define R_HA 1
#endif
#ifndef R_HB
#define R_HB 1
#endif
#ifndef R_HC
#define R_HC 1
#endif
#ifndef R_G2
#define R_G2 1
#endif
#ifndef R_LN
#define R_LN 1
#endif
#ifndef R_SC_
#define R_SC_ 1
#endif
#ifndef R_TK
#define R_TK 1
#endif
#ifndef R_GA
#define R_GA 1
#endif
#ifndef R_QKV
#define R_QKV 1
#endif
#ifndef R_AT
#define R_AT 1
#endif
#ifndef R_SWO
#define R_SWO 1
#endif
__global__ __launch_bounds__(512, 2) void mega_fwd(P p) {
  extern __shared__ __attribute__((aligned(16))) unsigned char shm[];
  LAS unsigned char* lds = (LAS unsigned char*)shm;
  cooperative_groups::grid_group grid = cooperative_groups::this_grid();
  const int bid = blockIdx.x, nb = gridDim.x;
  volatile LAS unsigned* xst = (volatile LAS unsigned*)(lds + 131072);
  if (threadIdx.x < 4) xst[threadIdx.x] = 0u;
  __syncthreads();
  const XcdBarrier xb = xcd_barrier_post((unsigned*)(p.ws + WS_CTL), xst);
  float* hA = (float*)(p.ws + WS_HA); bf16_t* hb = (bf16_t*)(p.ws + WS_HB16); const float* z = (const float*)(p.ws + R_Z);
  _Pragma("nounroll") for (int r_ = 0; r_ < R_PREP; ++r_) { phase_prep(p, lds, bid, nb); grid.sync(); }
  _Pragma("nounroll") for (int r_ = 0; r_ < R_G1; ++r_) { phase_gemm1(p, lds, bid, nb); xcd_barrier(xb); }
  _Pragma("nounroll") for (int r_ = 0; r_ < R_HA; ++r_) { phase_hgrn_a(p, lds, bid, nb); xcd_barrier(xb); }
  _Pragma("nounroll") for (int r_ = 0; r_ < R_HB; ++r_) { phase_hgrn_b(p, bid, nb); xcd_barrier(xb); }
  _Pragma("nounroll") for (int r_ = 0; r_ < R_HC; ++r_) { phase_hgrn_c(p, bid, nb); xcd_barrier(xb); }
  _Pragma("nounroll") for (int r_ = 0; r_ < R_G2; ++r_) { phase_gemm2(p, lds, bid, nb); xcd_barrier(xb); }
  _Pragma("nounroll") for (int r_ = 0; r_ < R_LN; ++r_) { phase_ln(z, p.ln_mix_g, p.ln_mix_b, hA, hb, bid, nb); xcd_barrier(xb); }
  _Pragma("nounroll") for (int r_ = 0; r_ < R_SC_; ++r_) { phase_peer_scores(p, 0, lds, bid, nb); xcd_barrier(xb); }
  _Pragma("nounroll") for (int r_ = 0; r_ < R_TK; ++r_) { phase_peer_topk(p, 0, bid, nb); xcd_barrier(xb); }
  _Pragma("nounroll") for (int r_ = 0; r_ < R_GA; ++r_) { phase_peer_gather(p, 0, hA, p.out, lds, bid, nb); xcd_barrier(xb); }
  _Pragma("nounroll") for (int r_ = 0; r_ < R_QKV; ++r_) { phase_gemm_qkv(p, lds, bid, nb); xcd_barrier(xb); }
  _Pragma("nounroll") for (int r_ = 0; r_ < R_AT; ++r_) { phase_attn(p, bid, nb); xcd_barrier(xb); }
  _Pragma("nounroll") for (int r_ = 0; r_ < R_SWO; ++r_) { phase_gemm_swo(p, lds, bid, nb); xcd_barrier(xb); }
  _Pragma("nounroll") for (int r_ = 0; r_ < R_LN; ++r_) { phase_ln(z, p.ln_mix_g + 1024, p.ln_mix_b + 1024, hA, hb, bid, nb); xcd_barrier(xb); }
  _Pragma("nounroll") for (int r_ = 0; r_ < R_SC_; ++r_) { phase_peer_scores(p, 1, lds, bid, nb); xcd_barrier(xb); }
  _Pragma("nounroll") for (int r_ = 0; r_ < R_TK; ++r_) { phase_peer_topk(p, 1, bid, nb); xcd_barrier(xb); }
  _Pragma("nounroll") for (int r_ = 0; r_ < R_GA; ++r_) { phase_peer_gather(p, 1, hA, p.out, lds, bid, nb); if (r_ + 1 < R_GA) xcd_barrier(xb); }
}
}

extern "C" void kernel_launch(void* const* d_in, const int* in_sizes, int n_in, void* d_out, int out_size, void* d_ws, size_t ws_size, hipStream_t stream) {
  constexpr int LDSB = 131072 + 16;
  static int grid_blocks = 0;
  if (!grid_blocks) {
    int dev = 0, cus = 0, per_cu = 0;
    hipGetDevice(&dev);
    hipDeviceGetAttribute(&cus, hipDeviceAttributeMultiprocessorCount, dev);
    hipFuncSetAttribute((const void*)mk::mega_fwd, hipFuncAttributeMaxDynamicSharedMemorySize, LDSB);
    hipOccupancyMaxActiveBlocksPerMultiprocessor(&per_cu, (const void*)mk::mega_fwd, 512, LDSB);
    if (per_cu < 1) per_cu = 1;
    if (per_cu > 1) per_cu = 1;
    grid_blocks = cus * per_cu;
  }
  mk::P p{};
  p.x = (const float*)d_in[0]; p.pos = (const int*)d_in[1]; p.hg_w_in = (const float*)d_in[2]; p.hg_lb = (const float*)d_in[3]; p.hg_norm_w = (const float*)d_in[4];
  p.hg_w_o = (const float*)d_in[5]; p.sw_w_q = (const float*)d_in[6]; p.sw_sinks = (const float*)d_in[7]; p.sw_w_o = (const float*)d_in[8]; p.w_kv = (const float*)d_in[9];
  p.peer_w_q = (const float*)d_in[10]; p.peer_sk = (const float*)d_in[11]; p.peer_u = (const float*)d_in[12]; p.peer_v = (const float*)d_in[13];
  p.ln_mix_g = (const float*)d_in[14]; p.ln_mix_b = (const float*)d_in[15]; p.ln_ffn_g = (const float*)d_in[16]; p.ln_ffn_b = (const float*)d_in[17];
  p.out = (float*)d_out; p.ws = (unsigned char*)d_ws;
  hipMemsetAsync(d_ws, 0, XCD_BAR_WORDS * 4, stream);
  void* args[] = {&p};
  hipError_t e = hipLaunchCooperativeKernel((const void*)mk::mega_fwd, dim3(grid_blocks), dim3(512), args, LDSB, stream);
  if (e != hipSuccess) fprintf(stderr, "cooperative launch failed: %s (grid %d)\n", hipGetErrorString(e), grid_blocks);
}
```
